# Optimizing an MI355X kernel written in HIP

```python
import jax, jax.numpy as jnp
from jax import lax
import numpy as np

D_MODEL = 2048
BATCH = 4
SEQ = 4096
DEPTH = 2

D_MIX = D_MODEL
D_FOURIER = D_MIX // 2
D_ATTN = D_MIX - D_FOURIER
HEAD_DIM = 128
N_FOURIER_GROUPS = D_FOURIER // HEAD_DIM
N_HEADS = D_ATTN // HEAD_DIM
DILATED_PATTERNS = ((128, 1), (512, 4), (2048, 16))
ROPE_THETA = 10000.0
D_FF = 5632
N_MOD = 9
EPS = 1e-6
MASK_VALUE = -1e30

kernel_name = "hybrid_fnet_dilated_attn_macaron_encoder"


def rms_norm(x, gain=None):
    xf = x.astype(jnp.float32)
    y = xf * lax.rsqrt(jnp.mean(xf * xf, axis=-1, keepdims=True) + EPS)
    if gain is not None:
        y = y * gain.astype(jnp.float32)
    return y.astype(x.dtype)


def modulate(h, shift, scale):
    return h * (1.0 + scale[:, None, :]) + shift[:, None, :]


def swiglu(h, w_gu, w_down):
    g, u = jnp.split(h @ w_gu, 2, axis=-1)
    return (jax.nn.silu(g) * u) @ w_down


def rope(t, positions):
    half = HEAD_DIM // 2
    inv_freq = ROPE_THETA ** (-jnp.arange(half, dtype=jnp.float32) / half)
    ang = positions.astype(jnp.float32)[:, None] * inv_freq[None, :]
    cos = jnp.cos(ang)[None, :, None, :]
    sin = jnp.sin(ang)[None, :, None, :]
    t1, t2 = t[..., :half], t[..., half:]
    return jnp.concatenate([t1 * cos - t2 * sin, t2 * cos + t1 * sin], axis=-1)


def dilated_branch(q, k, v, window, dilation):
    B, S, H, Dh = q.shape
    L = S // dilation
    reach = (window // 2) // dilation
    blk = reach
    nb = -(-L // blk)
    Lp = nb * blk

    def to_sub(a):
        return a.reshape(B, L, dilation, H, Dh).transpose(0, 2, 3, 1, 4)

    qs = jnp.pad(to_sub(q), ((0, 0), (0, 0), (0, 0), (0, Lp - L), (0, 0)))
    qs = qs.reshape(B, dilation, H, nb, blk, Dh)

    def key_bands(a):
        ap = jnp.pad(to_sub(a), ((0, 0), (0, 0), (0, 0), (blk, Lp - L + blk), (0, 0)))
        ap = ap.reshape(B, dilation, H, nb + 2, blk, Dh)
        return jnp.concatenate([ap[:, :, :, :-2], ap[:, :, :, 1:-1], ap[:, :, :, 2:]], axis=4)

    kb = key_bands(k)
    vb = key_bands(v)
    t_q = jnp.arange(nb)[:, None, None] * blk + jnp.arange(blk)[None, :, None]
    t_k = (jnp.arange(nb)[:, None, None] - 1) * blk + jnp.arange(3 * blk)[None, None, :]
    valid = (jnp.abs(t_q - t_k) <= reach) & (t_k >= 0) & (t_k < L)

    s = jnp.einsum('brhnid,brhnjd->brhnij', qs, kb) * (Dh ** -0.5)
    s = jnp.where(valid, s, MASK_VALUE)
    m = jnp.max(s, axis=-1, keepdims=True)
    p = jnp.exp(s - m)
    l = jnp.sum(p, axis=-1, keepdims=True)
    o = jnp.einsum('brhnij,brhnjd->brhnid', p, vb) / l
    lse = (m + jnp.log(l))[..., 0]
    o = o.reshape(B, dilation, H, Lp, Dh)[:, :, :, :L].transpose(0, 3, 1, 2, 4).reshape(B, S, H, Dh)
    lse = lse.reshape(B, dilation, H, Lp)[:, :, :, :L].transpose(0, 3, 1, 2).reshape(B, S, H)
    return o, lse


def hybrid_mixer(h, w_in, w_fourier, g_fourier_out, g_attn_out, w_out):
    B, S, _ = h.shape
    proj = h @ w_in
    u, q, k, v = jnp.split(proj, [D_FOURIER, D_FOURIER + D_ATTN, D_FOURIER + 2 * D_ATTN], axis=-1)

    u = u.reshape(B, S, N_FOURIER_GROUPS, HEAD_DIM).astype(jnp.float32)
    f = jnp.fft.fft2(u, axes=(1, 3), norm="ortho").real
    y_f = jnp.einsum('bsgc,gce->bsge', f, w_fourier.astype(jnp.float32)).reshape(B, S, D_FOURIER)

    pos = jnp.arange(S)
    q = rope(q.reshape(B, S, N_HEADS, HEAD_DIM).astype(jnp.float32), pos)
    k = rope(k.reshape(B, S, N_HEADS, HEAD_DIM).astype(jnp.float32), pos)
    v = v.reshape(B, S, N_HEADS, HEAD_DIM).astype(jnp.float32)
    branches = [dilated_branch(q, k, v, w, d) for (w, d) in DILATED_PATTERNS]
    outs = jnp.stack([b[0] for b in branches], axis=0)
    lses = jnp.stack([b[1] for b in branches], axis=0)
    wts = jax.nn.softmax(lses, axis=0)
    y_a = jnp.einsum('pbsh,pbshd->bshd', wts, outs).reshape(B, S, D_ATTN)

    y = jnp.concatenate([rms_norm(y_f, g_fourier_out), rms_norm(y_a, g_attn_out)], axis=-1)
    return y.astype(h.dtype) @ w_out


def setup_inputs(seed: int = 0) -> dict:
    key = jax.random.key(seed)
    ks = jax.random.split(key, 16)
    f32 = jnp.float32
    n = lambda k, shape, s: jax.random.normal(k, shape, f32) * s
    return {
        "x": n(ks[0], (BATCH, SEQ, D_MODEL), 1.0),
        "c": n(ks[1], (BATCH, D_MODEL), 1.0),
        "w_ada": n(ks[2], (DEPTH, D_MODEL, N_MOD * D_MODEL), D_MODEL ** -0.5),
        "b_ada": n(ks[3], (DEPTH, N_MOD * D_MODEL), 0.01),
        "w_ffn1_gu": n(ks[4], (DEPTH, D_MODEL, 2 * D_FF), D_MODEL ** -0.5),
        "w_ffn1_down": n(ks[5], (DEPTH, D_FF, D_MODEL), D_FF ** -0.5),
        "w_mix_in": n(ks[6], (DEPTH, D_MODEL, D_FOURIER + 3 * D_ATTN), D_MODEL ** -0.5),
        "w_fourier": n(ks[7], (DEPTH, N_FOURIER_GROUPS, HEAD_DIM, HEAD_DIM), HEAD_DIM ** -0.5),
        "g_fourier_out": 1.0 + n(ks[8], (DEPTH, D_FOURIER), 0.02),
        "g_attn_out": 1.0 + n(ks[9], (DEPTH, D_ATTN), 0.02),
        "w_mix_out": n(ks[10], (DEPTH, D_MIX, D_MODEL), D_MIX ** -0.5),
        "w_ffn2_gu": n(ks[11], (DEPTH, D_MODEL, 2 * D_FF), D_MODEL ** -0.5),
        "w_ffn2_down": n(ks[12], (DEPTH, D_FF, D_MODEL), D_FF ** -0.5),
        "g_final": 1.0 + n(ks[13], (D_MODEL,), 0.02),
    }


def reference(x, c, w_ada, b_ada, w_ffn1_gu, w_ffn1_down, w_mix_in, w_fourier,
              g_fourier_out, g_attn_out, w_mix_out, w_ffn2_gu, w_ffn2_down, g_final):
    c_act = jax.nn.silu(c)
    for l in range(DEPTH):
        mod = c_act @ w_ada[l] + b_ada[l]
        sh1, sc1, g1, sh2, sc2, g2, sh3, sc3, g3 = jnp.split(mod, N_MOD, axis=-1)
        h = modulate(rms_norm(x), sh1, sc1)
        x = x + 0.5 * g1[:, None, :] * swiglu(h, w_ffn1_gu[l], w_ffn1_down[l])
        h = modulate(rms_norm(x), sh2, sc2)
        x = x + g2[:, None, :] * hybrid_mixer(h, w_mix_in[l], w_fourier[l], g_fourier_out[l],
                                               g_attn_out[l], w_mix_out[l])
        h = modulate(rms_norm(x), sh3, sc3)
        x = x + 0.5 * g3[:, None, :] * swiglu(h, w_ffn2_gu[l], w_ffn2_down[l])
    return rms_norm(x, g_final)
```

```cpp
#include <hip/hip_runtime.h>
#include <cstdio>
#include <cstdint>
namespace pg8 {
#define PG8_LAS __attribute__((address_space(3)))
typedef unsigned short bf16_t;
typedef short bf16x8 __attribute__((ext_vector_type(8)));
typedef float f32x4 __attribute__((ext_vector_type(4)));
typedef unsigned u32x4 __attribute__((ext_vector_type(4)));
constexpr int BM = 256, BK = 64, HALF = 128, HTB = HALF * BK * 2  , STAGE_BYTES = 8 * HTB, NXCD = 8, WGM = 8;

__host__ __device__ __forceinline__ int lds_byte(int r, int c) { const int st = (r >> 4) * 2 + (c >> 5), rr = r & 15, cc = c & 31, ob = rr * 64 + cc * 2; return st * 1024 + (ob ^ (((ob >> 9) & 1) << 5)); }
__host__ __device__ __forceinline__ void stage_rc(int b, int& R, int& C) { const int st = b / 1024, sb = b % 1024, swz = sb ^ (((sb >> 9) & 1) << 5); R = (st >> 1) * 16 + swz / 64; C = (st & 1) * 32 + (swz % 64) / 2; }
__host__ __device__ __forceinline__ int perm32(int rho) { const int n = rho >> 4, i = rho & 15; return 8 * (i >> 2) + 4 * n + (i & 3); }

struct Unit { int pm, pn; };
struct Gemm { const bf16_t* A; const bf16_t* Bt; int M, N, K; };

struct StaticOrder {
    int nM, nN, nwg, G, c;
    __host__ __device__ void init(int M, int N, int G_, int c_) { nM = M / BM; nN = N / BM; nwg = nM * nN; G = G_; c = c_; }
    __host__ __device__ bool next(int i, Unit& u) const {
        const long L = (long)i * G + c; if (L >= nwg) return false;
        int wgid = (int)L; { const int q = nwg / NXCD, r = nwg % NXCD, xcd = wgid % NXCD, off = wgid / NXCD; wgid = (xcd < r ? xcd * (q + 1) : r * (q + 1) + (xcd - r) * q) + off; }
        const int nig = WGM * nN, gid = wgid / nig, fm = gid * WGM, gsz = (nM - fm) < WGM ? (nM - fm) : WGM;
        u.pm = fm + ((wgid % nig) % gsz); u.pn = (wgid % nig) / gsz; return true;
    }
    __device__ __forceinline__ void a_ready(const Unit&) const {}
    __device__ __forceinline__ void done(const Unit&) const {}
};

template <int MC, int NC, int WG = WGM> struct StaticOrderT {
    static constexpr int nM = MC / BM, nN = NC / BM, nwg = nM * nN;
    int G, c;
    __host__ __device__ void init(int G_, int c_) { G = G_; c = c_; }
    __host__ __device__ bool next(int i, Unit& u) const {
        const long L = (long)i * G + c; if (L >= nwg) return false;
        int wgid = (int)L; { constexpr int q = nwg / NXCD, r = nwg % NXCD; const int xcd = wgid % NXCD, off = wgid / NXCD; wgid = (xcd < r ? xcd * (q + 1) : r * (q + 1) + (xcd - r) * q) + off; }
        constexpr int nig = WG * nN; const int gid = wgid / nig, fm = gid * WG, gsz = (nM - fm) < WG ? (nM - fm) : WG;
        u.pm = fm + ((wgid % nig) % gsz); u.pn = (wgid % nig) / gsz; return true;
    }
    __device__ __forceinline__ void a_ready(const Unit&) const {}
    __device__ __forceinline__ void done(const Unit&) const {}
};
__device__ __forceinline__ unsigned cvt_pk_bf16(float lo, float hi) { unsigned r; asm volatile("v_cvt_pk_bf16_f32 %0, %1, %2" : "=v"(r) : "v"(lo), "v"(hi)); return r; }
template <class Epi, class Sched, bool ALIGN_EPI = false, bool SP2 = false, int KC = 0, bool KREV = false>
__device__ __forceinline__ void gemm_phase(PG8_LAS unsigned char* lds, const Gemm g, const Sched& S, const Epi& E, const int wave_id) {
    int tid_; asm volatile("v_mbcnt_lo_u32_b32 %0, -1, 0\n\tv_mbcnt_hi_u32_b32 %0, -1, %0" : "=v"(tid_)); tid_ += 64 * wave_id;
    const int tid = tid_, wid = __builtin_amdgcn_readfirstlane(tid >> 6), lane = tid & 63, wr = wid >> 2, wc = wid & 3, fr = lane & 15, fq = lane >> 4;
    const int K = KC ? KC : g.K, nt = K / BK;
    unsigned voffA[2], voffB[2];
#pragma unroll
    for (int i = 0; i < 2; ++i) { int R, C; stage_rc(tid * 16 + i * 8192, R, C); const int Rb = Epi::PERM ? ((R & ~31) + perm32(R & 31)) : R;
        voffA[i] = (unsigned)(R * K + C) * 2u; voffB[i] = (unsigned)(Rb * K + C) * 2u; }
    const size_t kstep = (size_t)(BK * 2);
#define PG8_KADV(p, n) (KREV ? (p) - (n) : (p) + (n))
    const size_t hstep = (size_t)HALF * K * 2;
    const size_t tstep = 2 * hstep;
    const unsigned ldsw = (unsigned)wid * 1024u;
    const int aoff = lds_byte(wr * 64 + fr, fq * 8), boff = lds_byte(wc * 32 + fr, fq * 8);
#define PG8_SA(b, h) (((b) * 2 + (h)) * HTB)
#define PG8_SB(b, h) ((4 + (b) * 2 + (h)) * HTB)
#define PG8_STAGE(bufoff, gbase, voff) do { _Pragma("unroll") for (int _i = 0; _i < 2; ++_i) \
        __builtin_amdgcn_global_load_lds((const unsigned*)((const char*)(gbase) + (voff)[_i]), (PG8_LAS unsigned*)(lds + (bufoff) + ldsw + _i * 8192), 16, 0, 0); } while (0)
#define PG8_LDA(dst, b, h) do { _Pragma("unroll") for (int m = 0; m < 4; ++m) _Pragma("unroll") for (int k = 0; k < 2; ++k) dst[m][k] = *(const PG8_LAS bf16x8*)(lds + PG8_SA(b, h) + aoff + m * 2048 + k * 1024); } while (0)
#define PG8_LDB(dst, b, h) do { _Pragma("unroll") for (int n = 0; n < 2; ++n) _Pragma("unroll") for (int k = 0; k < 2; ++k) dst[n][k] = *(const PG8_LAS bf16x8*)(lds + PG8_SB(b, h) + boff + n * 2048 + k * 1024); } while (0)
#define PG8_MMA(ai, bj, At, Bt) do { __builtin_amdgcn_s_setprio(1); _Pragma("unroll") for (int m = 0; m < 4; ++m) _Pragma("unroll") for (int n = 0; n < 2; ++n) _Pragma("unroll") for (int k = 0; k < 2; ++k) \
        acc[ai][bj][m][n] = __builtin_amdgcn_mfma_f32_16x16x32_bf16(Bt[n][k], At[m][k], acc[ai][bj][m][n], 0, 0, 0); __builtin_amdgcn_s_setprio(0); } while (0)
#define PG8_WAIT_V(n) asm volatile("s_waitcnt vmcnt(" #n ")" ::: "memory")
#define PG8_WAIT_L(n) asm volatile("s_waitcnt lgkmcnt(" #n ")" ::: "memory")
#define PG8_BAR __builtin_amdgcn_s_barrier()
#define PG8_SCHED __builtin_amdgcn_sched_barrier(0)
    Unit cur, nxt; int ui = 0;
    if (!S.next(0, cur)) return;
    f32x4 acc[2][2][4][2];
#pragma unroll
    for (int a = 0; a < 2; ++a)
#pragma unroll
        for (int b = 0; b < 2; ++b)
#pragma unroll
            for (int m = 0; m < 4; ++m)
#pragma unroll
                for (int n = 0; n < 2; ++n) acc[a][b][m][n] = (f32x4){0.f, 0.f, 0.f, 0.f};
    bf16x8 At[4][2], B0[2][2], B1[2][2];
    const char* cA = (const char*)g.A + (size_t)cur.pm * tstep; const char* cB = (const char*)g.Bt + (size_t)cur.pn * tstep;
    S.a_ready(cur);
    if constexpr (SP2) {
        PG8_STAGE(PG8_SB(0, 0), cB, voffB); PG8_STAGE(PG8_SB(0, 1), cB + hstep, voffB); PG8_STAGE(PG8_SA(0, 0), cA, voffA); PG8_STAGE(PG8_SA(0, 1), cA + hstep, voffA);
        if (wr == 1) PG8_BAR;
        PG8_WAIT_V(2); PG8_BAR;
        PG8_STAGE(PG8_SB(1, 0), PG8_KADV(cB, kstep), voffB); PG8_STAGE(PG8_SA(1, 0), PG8_KADV(cA, kstep), voffA); PG8_STAGE(PG8_SB(1, 1), PG8_KADV(cB + hstep, kstep), voffB);
        PG8_WAIT_V(6); PG8_BAR;
    } else {
        PG8_STAGE(PG8_SB(0, 0), cB, voffB); PG8_STAGE(PG8_SA(0, 0), cA, voffA); PG8_STAGE(PG8_SB(0, 1), cB + hstep, voffB); PG8_STAGE(PG8_SA(0, 1), cA + hstep, voffA);
        if (wr == 1) PG8_BAR;
        PG8_WAIT_V(4); PG8_BAR;
        PG8_STAGE(PG8_SB(1, 0), PG8_KADV(cB, kstep), voffB); PG8_STAGE(PG8_SA(1, 0), PG8_KADV(cA, kstep), voffA); PG8_STAGE(PG8_SB(1, 1), PG8_KADV(cB + hstep, kstep), voffB);
        PG8_WAIT_V(6); PG8_BAR;
    }
    for (;;) {
        const bool has_next = S.next(ui + 1, nxt);
        const char* nA = has_next ? (const char*)g.A + (size_t)nxt.pm * tstep : cA; const char* nB = has_next ? (const char*)g.Bt + (size_t)nxt.pn * tstep : cB;
        for (int t = 0; t < nt; t += 2) {
            if constexpr (Epi::MIDK) { if (t == nt / 2) E.midk(acc, cur, wr, wc, fr, fq); }
            const bool last = (t == nt - 2);
            const char* a1 = PG8_KADV(cA, (size_t)(t + 1) * kstep);
            const char* a2 = last ? nA : PG8_KADV(cA, (size_t)(t + 2) * kstep); const char* b2 = last ? nB : PG8_KADV(cB, (size_t)(t + 2) * kstep);
            const char* a3 = PG8_KADV(a2, kstep); const char* b3 = PG8_KADV(b2, kstep);
            if (last && has_next) S.a_ready(nxt);
            if constexpr (SP2) {
            PG8_LDB(B0, 0, 0); PG8_LDB(B1, 0, 1); PG8_SCHED; PG8_LDA(At, 0, 0); PG8_STAGE(PG8_SA(1, 1), a1 + hstep, voffA);
            PG8_WAIT_V(8); PG8_WAIT_L(0); PG8_BAR; PG8_MMA(0, 0, At, B0); PG8_MMA(0, 1, At, B1); PG8_BAR; PG8_SCHED;
            PG8_LDA(At, 0, 1); PG8_STAGE(PG8_SB(0, 0), b2, voffB); PG8_STAGE(PG8_SB(0, 1), b2 + hstep, voffB); PG8_STAGE(PG8_SA(0, 0), a2, voffA);
            PG8_WAIT_V(8); PG8_WAIT_L(0); PG8_BAR; PG8_MMA(1, 0, At, B0); PG8_MMA(1, 1, At, B1); PG8_BAR; PG8_SCHED;
            PG8_LDB(B0, 1, 0); PG8_LDB(B1, 1, 1); PG8_SCHED; PG8_LDA(At, 1, 0); PG8_STAGE(PG8_SA(0, 1), a2 + hstep, voffA);
            PG8_WAIT_V(8); PG8_WAIT_L(0); PG8_BAR; PG8_MMA(0, 0, At, B0); PG8_MMA(0, 1, At, B1); PG8_BAR; PG8_SCHED;
            PG8_LDA(At, 1, 1); PG8_STAGE(PG8_SB(1, 0), b3, voffB); PG8_STAGE(PG8_SB(1, 1), b3 + hstep, voffB); PG8_STAGE(PG8_SA(1, 0), a3, voffA);
            PG8_WAIT_V(8); PG8_WAIT_L(0); PG8_BAR; PG8_MMA(1, 0, At, B0); PG8_MMA(1, 1, At, B1); PG8_BAR; PG8_SCHED;
            } else {
            PG8_LDB(B0, 0, 0); PG8_SCHED; PG8_LDA(At, 0, 0); PG8_STAGE(PG8_SA(1, 1), a1 + hstep, voffA);
            PG8_WAIT_L(8); PG8_BAR; PG8_WAIT_L(0); PG8_MMA(0, 0, At, B0); PG8_BAR; PG8_SCHED;
            PG8_LDB(B1, 0, 1); PG8_STAGE(PG8_SB(0, 0), b2, voffB);
            PG8_BAR; PG8_WAIT_L(0); PG8_MMA(0, 1, At, B1); PG8_BAR;
            PG8_LDA(At, 0, 1); PG8_STAGE(PG8_SA(0, 0), a2, voffA);
            PG8_BAR; PG8_WAIT_L(0); PG8_MMA(1, 0, At, B0); PG8_BAR; PG8_SCHED;
            PG8_STAGE(PG8_SB(0, 1), b2 + hstep, voffB);
            PG8_WAIT_V(6); PG8_BAR; PG8_MMA(1, 1, At, B1); PG8_BAR;
            PG8_LDB(B0, 1, 0); PG8_SCHED; PG8_LDA(At, 1, 0); PG8_STAGE(PG8_SA(0, 1), a2 + hstep, voffA);
            PG8_WAIT_L(8); PG8_BAR; PG8_WAIT_L(0); PG8_MMA(0, 0, At, B0); PG8_BAR; PG8_SCHED;
            PG8_LDB(B1, 1, 1); PG8_STAGE(PG8_SB(1, 0), b3, voffB);
            PG8_BAR; PG8_WAIT_L(0); PG8_MMA(0, 1, At, B1); PG8_BAR;
            PG8_LDA(At, 1, 1); PG8_STAGE(PG8_SA(1, 0), a3, voffA);
            PG8_BAR; PG8_WAIT_L(0); PG8_MMA(1, 0, At, B0); PG8_BAR; PG8_SCHED;
            PG8_STAGE(PG8_SB(1, 1), b3 + hstep, voffB);
            PG8_WAIT_V(6); PG8_BAR; PG8_MMA(1, 1, At, B1); PG8_BAR;
            }
        }
        if constexpr (ALIGN_EPI) { if (wr == 0) PG8_BAR; }
        if constexpr (!Epi::AFTER_DRAIN) { E(acc, cur, wr, wc, fr, fq); S.done(cur); }
        if (!has_next) break;
#pragma unroll
        for (int a = 0; a < 2; ++a)
#pragma unroll
            for (int b = 0; b < 2; ++b)
#pragma unroll
                for (int m = 0; m < 4; ++m)
#pragma unroll
                    for (int n = 0; n < 2; ++n) acc[a][b][m][n] = (f32x4){0.f, 0.f, 0.f, 0.f};
        cur = nxt; cA = nA; cB = nB; ++ui;
        if constexpr (ALIGN_EPI) { if (wr == 1) PG8_BAR; }
    }
    PG8_WAIT_V(0);
    if constexpr (!ALIGN_EPI) { if (wr == 0) PG8_BAR; }
    PG8_BAR;
    if constexpr (Epi::AFTER_DRAIN) { E.fused(acc, cur, wr, wc, fr, fq, lds, wid, lane); S.done(cur); }
#undef PG8_SA
#undef PG8_KADV
#undef PG8_SB
#undef PG8_STAGE
#undef PG8_LDA
#undef PG8_LDB
#undef PG8_MMA
#undef PG8_WAIT_V
#undef PG8_WAIT_L
#undef PG8_BAR
#undef PG8_SCHED
}
}
constexpr int NWAVES = 8;
constexpr int BATCH = 4, SEQ = 4096, DM = 2048, FF = 5632, M = BATCH * SEQ, NH = 8, HD = 128, DF = 1024, DA = 1024, NMOD = 9, MODW = NMOD * DM;
constexpr float EPS = 1e-6f;
constexpr float QSCALE = 0.08838834764831845f * 1.4426950408889634f;

constexpr size_t MiB = 1u << 20;
constexpr size_t WS_CTL = 0, CTL_ZERO_BYTES = 1 * MiB;
constexpr size_t WS_MOD = 1 * MiB;
constexpr size_t WS_ROPE = 2 * MiB;
constexpr size_t WS_LSE = 6 * MiB;
constexpr size_t WS_YN = 7 * MiB + 768 * 1024;
constexpr size_t WS_NYQ = 7 * MiB + 512 * 1024;
constexpr size_t WS_PQ = 24 * MiB;
constexpr size_t WS_DMAT = 8 * MiB;
constexpr size_t WS_W = 72 * MiB;
constexpr size_t W_GU1 = 0, W_GU2 = 44 * MiB, W_D1 = 88 * MiB, W_D2 = 110 * MiB, W_F = 132 * MiB, W_QKV = 140 * MiB, W_OF = 152 * MiB, W_LAYER = 160 * MiB;
constexpr size_t WS_X = 392 * MiB;
constexpr size_t WS_H = 520 * MiB;
constexpr size_t WS_ACT = 584 * MiB;
constexpr size_t WS_UT = 760 * MiB;
constexpr size_t WS_HE = 792 * MiB;
constexpr size_t WS_HO = 1080 * MiB;
constexpr size_t WS_Q = 824 * MiB, WS_K = 856 * MiB, WS_V = 888 * MiB;
constexpr size_t WS_YF = 920 * MiB;
constexpr size_t WS_OP = 984 * MiB;
constexpr size_t WS_END = 1112 * MiB;
constexpr int CW_BAR = 4096;

constexpr int RING_BYTES = 131072;
constexpr int LDSCTL_OFF = RING_BYTES, MISC_OFF = LDSCTL_OFF + 320;
constexpr int LDS_BYTES = 147456;

#define GAS __attribute__((address_space(1)))
#define LAS __attribute__((address_space(3)))
typedef unsigned short bf16;
typedef unsigned v4u __attribute__((ext_vector_type(4)));
typedef unsigned v2u __attribute__((ext_vector_type(2)));
typedef float f32x4 __attribute__((ext_vector_type(4)));
typedef float f32x16 __attribute__((ext_vector_type(16)));
typedef short bf16x8 __attribute__((ext_vector_type(8)));
typedef short s16x4 __attribute__((ext_vector_type(4)));
typedef float f32x2_t __attribute__((ext_vector_type(2)));
typedef __bf16 bf16x2_t __attribute__((ext_vector_type(2)));
typedef GAS unsigned gu32;
#define LDS_WAIT() asm volatile("s_waitcnt lgkmcnt(0)" ::: "memory")
#define VM_WAIT() asm volatile("s_waitcnt vmcnt(0)" ::: "memory")
__device__ __forceinline__ unsigned pk2(float lo, float hi) { f32x2_t v = {lo, hi}; bf16x2_t b = __builtin_convertvector(v, bf16x2_t); return __builtin_bit_cast(unsigned, b); }
__device__ __forceinline__ v4u pk8(f32x4 a, f32x4 b) { v4u w; w.x = pk2(a[0], a[1]); w.y = pk2(a[2], a[3]); w.z = pk2(b[0], b[1]); w.w = pk2(b[2], b[3]); return w; }
__device__ __forceinline__ float bflo(unsigned u) { return __builtin_bit_cast(float, u << 16); }
__device__ __forceinline__ float bfhi(unsigned u) { return __builtin_bit_cast(float, u & 0xffff0000u); }
__device__ __forceinline__ float shfl_xor_f(float v, int o) {
    int l; asm volatile("v_mbcnt_lo_u32_b32 %0, -1, 0\n\tv_mbcnt_hi_u32_b32 %0, -1, %0" : "=v"(l));
    return __builtin_bit_cast(float, __builtin_amdgcn_ds_bpermute((l ^ o) << 2, __builtin_bit_cast(int, v)));
}
__device__ __forceinline__ float wave_sum(float v) {
#pragma unroll
    for (int o = 1; o < 64; o <<= 1) v += shfl_xor_f(v, o);
    return v;
}
#define XB_TMO      128
#define XB_XCNT(j)  (256  + 64 * (j))
#define XB_XSUB(j)  (1280 + 64 * (j))
#define XB_XGEN(j)  (2304 + 64 * (j))
#define XB_TOP      3328
#define XB_TOPGEN   3392
#define XCD_BAR_WORDS 3456
#define XB_SPIN_CAP (1u << 18)

__device__ __forceinline__ unsigned xb_ld(unsigned* p)              { return __hip_atomic_load(p, __ATOMIC_RELAXED, __HIP_MEMORY_SCOPE_AGENT); }
__device__ __forceinline__ unsigned xb_add(unsigned* p, unsigned v) { return __hip_atomic_fetch_add(p, v, __ATOMIC_RELAXED, __HIP_MEMORY_SCOPE_AGENT); }
__device__ __forceinline__ unsigned xb_xcc_id() { return (unsigned)__builtin_amdgcn_s_getreg((3 << 11) | 20) & 0xFu; }
#define XB_SPIN(cond, bar) do { unsigned _sp = 0; while (cond) { __builtin_amdgcn_s_sleep(1); \
    if ((++_sp & 255u) == 0u) { if (xb_ld(&(bar)[XB_TMO])) break; if (_sp > XB_SPIN_CAP) { atomicAdd(&(bar)[XB_TMO], 1u); break; } } } } while (0)

struct XcdBarrier {
    unsigned* bar; unsigned x;
    volatile LAS unsigned* st;
    int wv;
};
__device__ __forceinline__ int xb_lane() { int l; asm volatile("v_mbcnt_lo_u32_b32 %0, -1, 0\n\tv_mbcnt_hi_u32_b32 %0, -1, %0" : "=v"(l)); return l; }

__device__ __forceinline__ XcdBarrier xcd_barrier_post(unsigned* bar, volatile LAS unsigned* st) {
    XcdBarrier b; b.bar = bar; b.x = xb_xcc_id(); b.st = st; b.wv = 0;
    if (threadIdx.x == 0) (void)xb_add(&bar[XB_XCNT(b.x)], 1u);
    return b;
}
__device__ __forceinline__ void xcd_barrier_complete(unsigned* bar, unsigned x, unsigned& nloc, unsigned& nx) {
    const unsigned G = gridDim.x * gridDim.y * gridDim.z;
    unsigned sum, cnt, mine, sp = 0u;
    for (;;) {
        sum = 0u; cnt = 0u; mine = 0u;
#pragma unroll
        for (unsigned j = 0; j < 16; ++j) { const unsigned c = xb_ld(&bar[XB_XCNT(j)]); sum += c; cnt += (c > 0u) ? 1u : 0u; mine = (j == x) ? c : mine; }
        if (sum == G) break;
        __builtin_amdgcn_s_sleep(1);
        if ((++sp & 255u) == 0u) { if (xb_ld(&bar[XB_TMO])) break; if (sp > XB_SPIN_CAP) { atomicAdd(&bar[XB_TMO], 1u); break; } }
    }
    nloc = mine > 0u ? mine : 1u; nx = cnt > 0u ? cnt : 1u;
}

__device__ __forceinline__ void xcd_barrier(const XcdBarrier& b) {
    asm volatile("s_waitcnt vmcnt(0)" ::: "memory");
    __syncthreads();
    if (b.wv == 0 && xb_lane() == 0) {
        unsigned* bar = b.bar;
        __builtin_amdgcn_s_waitcnt(0);
        unsigned nloc = b.st[0], nx = b.st[1];
        if (nloc == 0u) { xcd_barrier_complete(bar, b.x, nloc, nx); b.st[0] = nloc; b.st[1] = nx; }
        const unsigned old = xb_add(&bar[XB_XSUB(b.x)], 1u);
        const unsigned gen = old / nloc;
        if (old + 1u == (gen + 1u) * nloc) {
            __builtin_amdgcn_fence(__ATOMIC_RELEASE, "agent");
            asm volatile("s_waitcnt vmcnt(0)" ::: "memory");
            const unsigned og = xb_add(&bar[XB_TOP], 1u);
            const unsigned tg = og / nx;
            if (og + 1u == (tg + 1u) * nx) xb_add(&bar[XB_TOPGEN], 1u);
            else XB_SPIN(xb_ld(&bar[XB_TOPGEN]) == tg, bar);
            __builtin_amdgcn_fence(__ATOMIC_ACQUIRE, "agent");
            xb_add(&bar[XB_XGEN(b.x)], 1u);
            asm volatile("s_waitcnt vmcnt(0)" ::: "memory");
        } else {
            XB_SPIN(xb_ld(&bar[XB_XGEN(b.x)]) == gen, bar);
            __builtin_amdgcn_fence(__ATOMIC_ACQUIRE, "agent");
            asm volatile("s_waitcnt vmcnt(0)" ::: "memory");
        }
    }
    __syncthreads();
}

typedef pg8::f32x4 accv;
struct EpiSwiGLU {
    static constexpr bool PERM = true, AFTER_DRAIN = false, MIDK = false;
    bf16* O;
    __device__ __forceinline__ void operator()(const accv (&acc)[2][2][4][2], const pg8::Unit& u, int wr, int wc, int fr, int fq) const {
        const int row0 = u.pm * 256 + wr * 64 + fr, col0 = u.pn * 128 + wc * 32 + 8 * fq;
#pragma unroll
        for (int ai = 0; ai < 2; ++ai)
#pragma unroll
            for (int m = 0; m < 4; ++m) {
                f32x4 a[2];
#pragma unroll
                for (int n = 0; n < 2; ++n)
#pragma unroll
                    for (int i = 0; i < 4; ++i) { const float g = acc[ai][0][m][n][i], up = acc[ai][1][m][n][i];
                        a[n][i] = g * __builtin_amdgcn_rcpf(1.f + __builtin_amdgcn_exp2f(-1.4426950408889634f * g)) * up; }
                *(v4u*)(O + (unsigned)((row0 + ai * 128 + m * 16) * FF + col0)) = pk8(a[0], a[1]);
            }
    }
};
template <int NP, int HALFSTEP, int XF32> struct EpiResid {
    static constexpr bool PERM = true, AFTER_DRAIN = false, MIDK = false;
    const void* xin; bf16* xout; const float* gate; const float* ssq;
    __device__ __forceinline__ void operator()(const accv (&acc)[2][2][4][2], const pg8::Unit& u, int wr, int wc, int fr, int fq) const {
        const int b = u.pm >> 4, row0 = u.pm * 256 + wr * 64 + fr, col0 = u.pn * 256 + wc * 32 + 8 * fq;
        f32x4 gv[2][2];
        if constexpr (XF32 == 0) {
#pragma unroll
            for (int bj = 0; bj < 2; ++bj)
#pragma unroll
                for (int n = 0; n < 2; ++n) asm volatile("global_load_dwordx4 %0, %1, off" : "=v"(gv[bj][n]) : "v"(gate + (unsigned)(b * MODW + col0 + bj * 128 + 4 * n)) : "memory");
        } else {
#pragma unroll
        for (int bj = 0; bj < 2; ++bj)
#pragma unroll
            for (int n = 0; n < 2; ++n) gv[bj][n] = *(const f32x4*)(gate + (unsigned)(b * MODW + col0 + bj * 128 + 4 * n)) * (HALFSTEP ? 0.5f : 1.f);
        }
        if constexpr (XF32 == 0) {
            v4u xr[4][2][2];
#define ER_LOAD(c_) do { _Pragma("unroll") for (int mm = 0; mm < 2; ++mm) _Pragma("unroll") for (int bj = 0; bj < 2; ++bj) \
                asm volatile("global_load_dwordx4 %0, %1, off" : "=v"(xr[c_][mm][bj]) : "v"((const bf16*)xin + (unsigned)((row0 + ((c_) >> 1) * 128 + (2 * ((c_) & 1) + mm) * 16) * DM + col0 + bj * 128)) : "memory"); } while (0)
#define ER_PIN(c_) asm volatile("" : "+v"(xr[c_][0][0]), "+v"(xr[c_][0][1]), "+v"(xr[c_][1][0]), "+v"(xr[c_][1][1]))
#define ER_PROC(c_) do { _Pragma("unroll") for (int mm = 0; mm < 2; ++mm) { const int ai = (c_) >> 1, m = 2 * ((c_) & 1) + mm, row = row0 + ai * 128 + m * 16; \
                _Pragma("unroll") for (int bj = 0; bj < 2; ++bj) { const unsigned off = (unsigned)(row * DM + col0 + bj * 128); const v4u xv = xr[c_][mm][bj]; \
                    const f32x4 x0 = (f32x4){bflo(xv[0]), bfhi(xv[0]), bflo(xv[1]), bfhi(xv[1])}, x1 = (f32x4){bflo(xv[2]), bfhi(xv[2]), bflo(xv[3]), bfhi(xv[3])}; \
                    *(v4u*)(xout + off) = pk8(x0 + gv[bj][0] * acc[ai][bj][m][0], x1 + gv[bj][1] * acc[ai][bj][m][1]); } } } while (0)
            ER_LOAD(0); ER_LOAD(1);
            asm volatile("s_waitcnt vmcnt(0)" ::: "memory");
            ER_PIN(0); ER_PIN(1);
            asm volatile("" : "+v"(gv[0][0]), "+v"(gv[0][1]), "+v"(gv[1][0]), "+v"(gv[1][1]));
            if (HALFSTEP) {
#pragma unroll
                for (int bj = 0; bj < 2; ++bj)
#pragma unroll
                    for (int n = 0; n < 2; ++n) gv[bj][n] = gv[bj][n] * 0.5f; }
            ER_PROC(0); ER_LOAD(2);
            ER_PROC(1); ER_LOAD(3);
            asm volatile("s_waitcnt vmcnt(8)" ::: "memory"); ER_PIN(2);
            ER_PROC(2);
            asm volatile("s_waitcnt vmcnt(4)" ::: "memory"); ER_PIN(3);
            ER_PROC(3);
            asm volatile("" ::: "memory");
#undef ER_LOAD
#undef ER_PIN
#undef ER_PROC
        } else {
#pragma unroll
        for (int ai = 0; ai < 2; ++ai) {
            v4u xr[4][2][2];
#pragma unroll
            for (int m = 0; m < 4; ++m)
#pragma unroll
                for (int bj = 0; bj < 2; ++bj) { const int row = row0 + ai * 128 + m * 16; const unsigned offi = (unsigned)(row * DM + col0 + bj * 128);
                    xr[m][bj][0] = *(const v4u*)((const float*)xin + offi); xr[m][bj][1] = *(const v4u*)((const float*)xin + offi + 4); }
            asm volatile("s_waitcnt vmcnt(0)" ::: "memory");
#pragma unroll
            for (int m = 0; m < 4; ++m) {
                const int row = row0 + ai * 128 + m * 16;
#pragma unroll
                for (int bj = 0; bj < 2; ++bj) { const unsigned off = (unsigned)(row * DM + col0 + bj * 128);
                    const f32x4 x0 = __builtin_bit_cast(f32x4, xr[m][bj][0]), x1 = __builtin_bit_cast(f32x4, xr[m][bj][1]);
                    *(v4u*)(xout + off) = pk8(x0 + gv[bj][0] * acc[ai][bj][m][0], x1 + gv[bj][1] * acc[ai][bj][m][1]); }
            }
            asm volatile("" ::: "memory");
        }
        }
    }
};
struct EpiUT {
    static constexpr bool PERM = true, AFTER_DRAIN = false, MIDK = false;
    bf16* UT;
    __device__ __forceinline__ void operator()(const accv (&acc)[2][2][4][2], const pg8::Unit& u, int wr, int wc, int fr, int fq) const {
        const int r0 = u.pm * 256 + wr * 64 + fr, c0 = u.pn * 256 + wc * 32 + 8 * fq;
#pragma unroll
        for (int ai = 0; ai < 2; ++ai)
#pragma unroll
            for (int m = 0; m < 4; ++m) { const int ch = r0 + ai * 128 + m * 16;
#pragma unroll
                for (int bj = 0; bj < 2; ++bj) { const int tok = c0 + bj * 128, b = tok >> 11, par = (tok >> 10) & 1, jp = tok & 1023;
                    *(v4u*)(UT + (unsigned)(par * (4096 * 1024) + (b * 1024 + ch) * 1024 + jp)) = pk8(acc[ai][bj][m][0], acc[ai][bj][m][1]); } }
    }
};
struct EpiQKV {
    static constexpr bool PERM = true, AFTER_DRAIN = false, MIDK = false;
    bf16 *Q, *K, *V; const float *rc, *rs;
    __device__ __forceinline__ void operator()(const accv (&acc)[2][2][4][2], const pg8::Unit& u, int wr, int wc, int fr, int fq) const {
        const int sect = u.pn >> 2, t = u.pn & 3, row0 = u.pm * 256 + wr * 64 + fr, j0 = wc * 32 + 8 * fq;
        if (sect == 2) {
#pragma unroll
            for (int ai = 0; ai < 2; ++ai)
#pragma unroll
                for (int m = 0; m < 4; ++m) { const int row = row0 + ai * 128 + m * 16;
#pragma unroll
                    for (int bj = 0; bj < 2; ++bj) *(v4u*)(V + (unsigned)(row * 1024 + t * 256 + bj * 128 + j0)) = pk8(acc[ai][bj][m][0], acc[ai][bj][m][1]); }
        } else {
            const int head = 2 * t + (j0 >> 6), d0 = j0 & 63; bf16* dst = sect ? K : Q; const float sc = sect ? 1.f : QSCALE;
            f32x4 tb[8][4];
#define EQ_LOAD(g_) do { const int pos_ = (row0 + ((g_) >> 2) * 128 + ((g_) & 3) * 16) & 4095; \
                _Pragma("unroll") for (int n = 0; n < 2; ++n) { \
                    asm volatile("global_load_dwordx4 %0, %1, off" : "=v"(tb[g_][n]) : "v"(rc + (unsigned)(pos_ * 64 + d0 + 4 * n)) : "memory"); \
                    asm volatile("global_load_dwordx4 %0, %1, off" : "=v"(tb[g_][2 + n]) : "v"(rs + (unsigned)(pos_ * 64 + d0 + 4 * n)) : "memory"); } } while (0)
#define EQ_PROC(g_) do { asm volatile("" : "+v"(tb[g_][0]), "+v"(tb[g_][1]), "+v"(tb[g_][2]), "+v"(tb[g_][3])); \
                const int ai = (g_) >> 2, m = (g_) & 3, row = row0 + ai * 128 + m * 16; f32x4 o1[2], o2[2]; \
                _Pragma("unroll") for (int n = 0; n < 2; ++n) { const f32x4 cv = tb[g_][n], sv = tb[g_][2 + n], x1 = acc[ai][0][m][n], x2 = acc[ai][1][m][n]; \
                    o1[n] = (x1 * cv - x2 * sv) * sc; o2[n] = (x2 * cv + x1 * sv) * sc; } \
                bf16* p = dst + (unsigned)(row * 1024 + head * 128 + d0); \
                *(v4u*)p = pk8(o1[0], o1[1]); *(v4u*)(p + 64) = pk8(o2[0], o2[1]); } while (0)
            EQ_LOAD(0); EQ_LOAD(1);
            asm volatile("s_waitcnt vmcnt(4)" ::: "memory"); EQ_PROC(0); EQ_LOAD(2);
            asm volatile("s_waitcnt vmcnt(6)" ::: "memory"); EQ_PROC(1); EQ_LOAD(3);
            asm volatile("s_waitcnt vmcnt(6)" ::: "memory"); EQ_PROC(2); EQ_LOAD(4);
            asm volatile("s_waitcnt vmcnt(6)" ::: "memory"); EQ_PROC(3); EQ_LOAD(5);
            asm volatile("s_waitcnt vmcnt(6)" ::: "memory"); EQ_PROC(4); EQ_LOAD(6);
            asm volatile("s_waitcnt vmcnt(6)" ::: "memory"); EQ_PROC(5); EQ_LOAD(7);
            asm volatile("s_waitcnt vmcnt(6)" ::: "memory"); EQ_PROC(6);
            asm volatile("s_waitcnt vmcnt(2)" ::: "memory"); EQ_PROC(7);
            asm volatile("" ::: "memory");
#undef EQ_LOAD
#undef EQ_PROC
        }
    }
};
struct EpiPQ {
    static constexpr bool PERM = true, AFTER_DRAIN = false, MIDK = false;
    float* O;
    __device__ __forceinline__ void operator()(const accv (&acc)[2][2][4][2], const pg8::Unit& u, int wr, int wc, int fr, int fq) const {
        const int row0 = u.pm * 256 + wr * 64 + fr, col0 = u.pn * 256 + wc * 32 + 8 * fq;
#pragma unroll
        for (int ai = 0; ai < 2; ++ai)
#pragma unroll
            for (int m = 0; m < 4; ++m)
#pragma unroll
                for (int bj = 0; bj < 2; ++bj) { float* p = O + (unsigned)((row0 + ai * 128 + m * 16) * 4096 + col0 + bj * 128); *(f32x4*)p = acc[ai][bj][m][0]; *(f32x4*)(p + 4) = acc[ai][bj][m][1]; }
    }
};

template <int XF32> __device__ __forceinline__ void ld_row8(const void* rowp, int lane, int j, f32x4& a, f32x4& b) {
    if (XF32) { const f32x4* p = (const f32x4*)rowp + 2 * (lane + 64 * j); a = p[0]; b = p[1]; }
    else { const v4u xv = ((const v4u*)rowp)[lane + 64 * j]; a = (f32x4){bflo(xv[0]), bfhi(xv[0]), bflo(xv[1]), bfhi(xv[1])}; b = (f32x4){bflo(xv[2]), bfhi(xv[2]), bflo(xv[3]), bfhi(xv[3])}; }
}
__device__ __forceinline__ float ssq8(const f32x4& a, const f32x4& b) { return ((a[0] * a[0] + a[1] * a[1]) + (a[2] * a[2] + a[3] * a[3])) + ((b[0] * b[0] + b[1] * b[1]) + (b[2] * b[2] + b[3] * b[3])); }
__device__ __forceinline__ void p0_mod(LAS unsigned char* lds, const float* c, const float* w_ada, const float* b_ada, float* mod, int tid, int wave, int lane, int G) {
    LAS float* sl = (LAS float*)lds;
    LAS float* red = (LAS float*)(lds + 32768);
    for (int i = tid; i < 4 * DM; i += NWAVES * 64) { const float v = c[i]; sl[i] = v / (1.f + expf(-v)); }
    __syncthreads();
    for (int w = blockIdx.x; w < 256; w += G) {
        const int cg0 = 144 * w, l = cg0 / MODW, n0 = cg0 % MODW;
        if (lane < 36) {
            const float* Wp = w_ada + (size_t)l * DM * MODW + (size_t)(wave * 256) * MODW + n0 + 4 * lane;
            f32x4 a0 = {0.f, 0.f, 0.f, 0.f}, a1 = a0, a2 = a0, a3 = a0;
#pragma unroll 8
            for (int k = 0; k < 256; ++k) { const f32x4 wv = *(const f32x4*)(Wp + (size_t)k * MODW); const int kk = wave * 256 + k;
                a0 += wv * sl[kk]; a1 += wv * sl[DM + kk]; a2 += wv * sl[2 * DM + kk]; a3 += wv * sl[3 * DM + kk]; }
            LAS float* r = red + (wave * 36 + lane) * 16;
            *(LAS f32x4*)(r) = a0; *(LAS f32x4*)(r + 4) = a1; *(LAS f32x4*)(r + 8) = a2; *(LAS f32x4*)(r + 12) = a3;
        }
        __syncthreads();
        if (tid < 144) { const int ls = tid >> 2, cp = tid & 3;
#pragma unroll
            for (int b = 0; b < 4; ++b) { float s = b_ada[(size_t)l * MODW + n0 + tid];
#pragma unroll
                for (int v = 0; v < 8; ++v) s += red[(v * 36 + ls) * 16 + b * 4 + cp];
                mod[((size_t)l * 4 + b) * MODW + n0 + tid] = s; } }
        __syncthreads();
    }
}
__device__ __forceinline__ void p0_fold(LAS unsigned char* lds, const float* w_mix_in, const float* w_fourier, unsigned char* wsW, int tid, int G) {
    LAS float* tab = (LAS float*)lds;
    LAS float* Mx = (LAS float*)(lds + 512);
    LAS float* Wb = (LAS float*)(lds + 512 + 65536);
    const int lane = tid & 63, wv = tid >> 6, r32 = lane & 31, hi = lane >> 5;
    if (tid < 128) tab[tid] = cospif((float)tid * (1.f / 64.f)) * 0.08838834764831845f;
    __syncthreads();
    for (int w = blockIdx.x; w < 256; w += G) {
        const int combo = w >> 3, l = combo >> 4, g = (combo >> 1) & 7, part = combo & 1;
        const float* Wf = w_fourier + ((size_t)(l * 8 + g) * 128) * 128;
        { f32x16 acc[2];
#pragma unroll
          for (int tt = 0; tt < 2; ++tt)
#pragma unroll
              for (int i = 0; i < 16; ++i) acc[tt][i] = 0.f;
          for (int half = 0; half < 2; ++half) {
#pragma unroll
              for (int q = 0; q < 4; ++q) { const int i = tid + 512 * q, kk = i >> 5, c4 = i & 31;
                  *(LAS f32x4*)(Wb + kk * 128 + 4 * c4) = *(const f32x4*)(Wf + (size_t)(64 * half + kk) * 128 + 4 * c4); }
              __syncthreads();
#pragma unroll
              for (int tt = 0; tt < 2; ++tt) { const int tile = wv * 2 + tt, tc = tile >> 2, te = tile & 3, c = tc * 32 + r32, e = te * 32 + r32;
#pragma unroll 8
                  for (int kk = 0; kk < 32; ++kk) { const int kl = 2 * kk + hi, k2 = 64 * half + kl;
                      acc[tt] = __builtin_amdgcn_mfma_f32_32x32x2f32(tab[(k2 * c - (part ? 32 : 0)) & 127], Wb[kl * 128 + e], acc[tt], 0, 0, 0); } }
              __syncthreads();
          }
#pragma unroll
          for (int tt = 0; tt < 2; ++tt) { const int tile = wv * 2 + tt, tc = tile >> 2, te = tile & 3, e = te * 32 + r32;
#pragma unroll
              for (int i = 0; i < 16; ++i) Mx[(tc * 32 + (i & 3) + 8 * (i >> 2) + 4 * hi) * 128 + e] = acc[tt][i]; } }
        bf16* WfT = (bf16*)(wsW + (size_t)l * W_LAYER + W_F);
        f32x4 pre[4];
#pragma unroll
        for (int q = 0; q < 4; ++q) { const int i = tid + 512 * q, kk = i >> 5, c4 = i & 31; pre[q] = *(const f32x4*)(w_mix_in + ((size_t)l * DM + (w & 7) * 256 + kk) * 4096 + g * 128 + 4 * c4); }
        __syncthreads();
        for (int kb4 = 0; kb4 < 4; ++kb4) {
            const int k0 = ((w & 7) * 4 + kb4) * 64;
#pragma unroll
            for (int q = 0; q < 4; ++q) { const int i = tid + 512 * q, kk = i >> 5, c4 = i & 31; LAS float* d = Wb + kk * 129 + 4 * c4; d[0] = pre[q][0]; d[1] = pre[q][1]; d[2] = pre[q][2]; d[3] = pre[q][3]; }
            if (kb4 < 3) {
#pragma unroll
                for (int q = 0; q < 4; ++q) { const int i = tid + 512 * q, kk = i >> 5, c4 = i & 31; pre[q] = *(const f32x4*)(w_mix_in + ((size_t)l * DM + k0 + 64 + kk) * 4096 + g * 128 + 4 * c4); } }
            __syncthreads();
            { const int tr = wv >> 2, te = wv & 3, e = te * 32 + r32;
              f32x16 acc;
#pragma unroll
              for (int i = 0; i < 16; ++i) acc[i] = 0.f;
#pragma unroll 8
              for (int kk = 0; kk < 64; ++kk) { const int cc = 2 * kk + hi;
                  acc = __builtin_amdgcn_mfma_f32_32x32x2f32(Wb[(tr * 32 + r32) * 129 + cc], Mx[cc * 128 + e], acc, 0, 0, 0); }
              bf16* dst = WfT + (size_t)(part * 1024 + g * 128 + e) * DM + k0 + tr * 32 + 4 * hi;
#pragma unroll
              for (int g4 = 0; g4 < 4; ++g4) { v2u o; o.x = pk2(acc[4 * g4], acc[4 * g4 + 1]); o.y = pk2(acc[4 * g4 + 2], acc[4 * g4 + 3]); *(v2u*)(dst + 8 * g4) = o; } }
            __syncthreads();
        }
    }
}
__device__ __forceinline__ void p0_dmat(LAS unsigned char* lds, bf16* Dm, int tid, int G) {
    LAS float* ct = (LAS float*)lds;
    for (int i = tid; i < 4096; i += NWAVES * 64) ct[i] = cospif((float)i * (1.f / 2048.f)) * (1.f / 64.f);
    __syncthreads();
    for (int w = blockIdx.x; w < 256; w += G)
        for (int it = 0; it < 4; ++it) { const int id = w * 2048 + it * 512 + tid, mat = id >> 17, rem = id & 131071, row = rem >> 7, j0 = (rem & 127) * 8;
            float v[8];
#pragma unroll
            for (int j = 0; j < 8; ++j) v[j] = ct[(row * (2 * (j0 + j) + (mat & 1)) - ((mat >> 1) ? 1024 : 0)) & 4095];
            v4u o; o.x = pk2(v[0], v[1]); o.y = pk2(v[2], v[3]); o.z = pk2(v[4], v[5]); o.w = pk2(v[6], v[7]);
            *(v4u*)(Dm + (size_t)mat * 1024 * 1024 + (size_t)row * 1024 + j0) = o; }
    __syncthreads();
}
__device__ __forceinline__ void tr_item(const float* W, int ldw, int k0, int n0src, bf16* WT, int ldt, int drow0, int dk0, const float* gain, LAS float* scr, int lane) {
    { f32x4 v[8];
#pragma unroll
      for (int i = 0; i < 8; ++i) v[i] = *(const f32x4*)(W + (size_t)(k0 + 8 * i + (lane >> 3)) * ldw + n0src + 4 * (lane & 7));
#pragma unroll
      for (int i = 0; i < 8; ++i) { const int kk = 8 * i + (lane >> 3); f32x4 t = v[i]; if (gain) t = t * gain[k0 + kk];
          LAS float* d = scr + kk * 33 + 4 * (lane & 7); d[0] = t[0]; d[1] = t[1]; d[2] = t[2]; d[3] = t[3]; } }
    LDS_WAIT(); asm volatile("" ::: "memory");
    const int c = lane & 7;
#pragma unroll
    for (int j = 0; j < 4; ++j) { const int n = (lane >> 3) + 8 * j; const LAS float* s = scr + (8 * c) * 33 + n;
        v4u o; o.x = pk2(s[0 * 33], s[1 * 33]); o.y = pk2(s[2 * 33], s[3 * 33]); o.z = pk2(s[4 * 33], s[5 * 33]); o.w = pk2(s[6 * 33], s[7 * 33]);
        *(v4u*)(WT + (size_t)(drow0 + n) * ldt + dk0 + 8 * c) = o; }
    LDS_WAIT(); asm volatile("" ::: "memory");
}
constexpr int IT_GU = (DM / 64) * (2 * FF / 32), IT_D = (FF / 64) * (DM / 32), IT_QKV = (DM / 64) * (3072 / 32), IT_O = (DM / 64) * (DM / 32), IT_LAYER = 2 * IT_GU + 2 * IT_D + IT_QKV + IT_O;
__device__ __forceinline__ void p0_weights(LAS unsigned char* lds, const float* const* in, unsigned char* wsW, int gw, int NGW, int wave, int lane) {
    LAS float* scr = (LAS float*)(lds + wave * 16384);
    for (int it = gw; it < 2 * IT_LAYER; it += NGW) {
        const int l = it / IT_LAYER; int r = it % IT_LAYER; unsigned char* wl = wsW + (size_t)l * W_LAYER;
        if (r < 2 * IT_GU) { const int f = r / IT_GU; r %= IT_GU; const int nblk = 2 * FF / 32, kb = r / nblk, nb = r % nblk, n0 = 32 * nb;
            const int j0 = n0 < FF ? n0 : n0 - FF, drow = (j0 >> 7) * 256 + (n0 < FF ? 0 : 128) + (j0 & 127);
            tr_item(in[f ? 11 : 4] + (size_t)l * DM * 2 * FF, 2 * FF, 64 * kb, n0, (bf16*)(wl + (f ? W_GU2 : W_GU1)), DM, drow, 64 * kb, nullptr, scr, lane); continue; }
        r -= 2 * IT_GU;
        if (r < 2 * IT_D) { const int f = r / IT_D; r %= IT_D; const int nblk = DM / 32, kb = r / nblk, nb = r % nblk;
            tr_item(in[f ? 12 : 5] + (size_t)l * FF * DM, DM, 64 * kb, 32 * nb, (bf16*)(wl + (f ? W_D2 : W_D1)), FF, 32 * nb, 64 * kb, nullptr, scr, lane); continue; }
        r -= 2 * IT_D;
        if (r < IT_QKV) { const int nblk = 3072 / 32, kb = r / nblk, nb = r % nblk, n = 32 * nb, sect = n >> 10, within = n & 1023, hh = within >> 7, d = within & 127;
            const int drow = sect == 2 ? 2048 + within : sect * 1024 + 256 * (hh >> 1) + (d >> 6) * 128 + (hh & 1) * 64 + (d & 63);
            tr_item(in[6] + (size_t)l * DM * 4096, 4096, 64 * kb, 1024 + n, (bf16*)(wl + W_QKV), DM, drow, 64 * kb, nullptr, scr, lane); continue; }
        r -= IT_QKV;
        { const int nblk = DM / 32, kb = r / nblk, nb = r % nblk, k0 = 64 * kb; const bool fh = k0 < 1024;
          tr_item(in[10] + (size_t)l * DM * DM, DM, k0, 32 * nb, (bf16*)(wl + W_OF), DM, 32 * nb, k0,
                  fh ? in[8] + (size_t)l * DF : in[9] + (size_t)l * DA - 1024, scr, lane); }
    }
}
__device__ __forceinline__ void p0_rope(float* rc, float* rs, int gt, int NT) {
    for (int i = gt; i < 4096 * 64; i += NT) { const int pos = i >> 6, fi = i & 63;
        const float invf = exp2f(-(float)fi * 0.20762050593046014f);
        const float ang = (float)pos * invf;
        const double rev = (double)ang * 0.15915494309189535; const float fr = (float)(rev - floor(rev));
        rc[i] = __builtin_amdgcn_cosf(fr); rs[i] = __builtin_amdgcn_sinf(fr); }
}
template <int XF32> __device__ __forceinline__ void norm_mod_phase(const void* x, const float* modl, int ch_shift, int ch_scale, bf16* H, int gw, int NGW, int lane) {
    const size_t rowb = XF32 ? (size_t)DM * 4 : (size_t)DM * 2;
    for (int blk = gw; blk < M / 8; blk += NGW) {
        const int r0 = blk * 8, b = r0 >> 12;
        const f32x4* shp = (const f32x4*)(modl + (size_t)b * MODW + ch_shift * DM); const f32x4* scp = (const f32x4*)(modl + (size_t)b * MODW + ch_scale * DM);
        f32x4 sh[4][2], sc[4][2];
#pragma unroll
        for (int j = 0; j < 4; ++j)
#pragma unroll
            for (int q = 0; q < 2; ++q) { sh[j][q] = shp[2 * (lane + 64 * j) + q]; sc[j][q] = scp[2 * (lane + 64 * j) + q] + 1.f; }
        for (int rr = 0; rr < 8; ++rr) {
            const unsigned char* xr = (const unsigned char*)x + (size_t)(r0 + rr) * rowb; f32x4 v[4][2]; float s = 0.f;
#pragma unroll
            for (int j = 0; j < 4; ++j) ld_row8<XF32>(xr, lane, j, v[j][0], v[j][1]);
#pragma unroll
            for (int j = 0; j < 4; ++j) s += ssq8(v[j][0], v[j][1]);
            const float rstd = 1.f / sqrtf(wave_sum(s) * (1.f / DM) + EPS);
            v4u* o = (v4u*)(H + (size_t)(r0 + rr) * DM);
#pragma unroll
            for (int j = 0; j < 4; ++j) o[lane + 64 * j] = pk8(v[j][0] * rstd * sc[j][0] + sh[j][0], v[j][1] * rstd * sc[j][1] + sh[j][1]);
        }
    }
}
__device__ __forceinline__ void norm_mod_fold_phase(const bf16* x, const float* modl, int ch_shift, int ch_scale, bf16* H, bf16* HE, bf16* HO, int gw, int NGW, int lane) {
    for (int blk = gw; blk < BATCH * 512; blk += NGW) {
        const int b = blk >> 9, t0 = (blk & 511) * 4;
        const f32x4* shp = (const f32x4*)(modl + (size_t)b * MODW + ch_shift * DM); const f32x4* scp = (const f32x4*)(modl + (size_t)b * MODW + ch_scale * DM);
        f32x4 sh[4][2], sc[4][2];
#pragma unroll
        for (int j = 0; j < 4; ++j)
#pragma unroll
            for (int q = 0; q < 2; ++q) { sh[j][q] = shp[2 * (lane + 64 * j) + q]; sc[j][q] = scp[2 * (lane + 64 * j) + q] + 1.f; }
        for (int tt = 0; tt < 4; ++tt) {
            const int t = t0 + tt, ra = t, rb = t ? SEQ - t : SEQ / 2;
            const bf16* xa = x + (size_t)(b * SEQ + ra) * DM; const bf16* xb = x + (size_t)(b * SEQ + rb) * DM;
            f32x4 va[4][2], vb[4][2]; float sa = 0.f, sb = 0.f;
#pragma unroll
            for (int j = 0; j < 4; ++j) { ld_row8<0>(xa, lane, j, va[j][0], va[j][1]); ld_row8<0>(xb, lane, j, vb[j][0], vb[j][1]); }
#pragma unroll
            for (int j = 0; j < 4; ++j) { sa += ssq8(va[j][0], va[j][1]); sb += ssq8(vb[j][0], vb[j][1]); }
            const float ra_ = 1.f / sqrtf(wave_sum(sa) * (1.f / DM) + EPS), rb_ = 1.f / sqrtf(wave_sum(sb) * (1.f / DM) + EPS);
            v4u* oa = (v4u*)(H + (size_t)(b * SEQ + ra) * DM); v4u* ob = (v4u*)(H + (size_t)(b * SEQ + rb) * DM);
            const int fr_ = b * 2048 + (t & 1) * 1024 + (t >> 1);
            v4u* oe = (v4u*)(HE + (size_t)fr_ * DM); v4u* oo = (v4u*)(HO + (size_t)fr_ * DM);
            const f32x4 z4 = {0.f, 0.f, 0.f, 0.f};
#pragma unroll
            for (int j = 0; j < 4; ++j) { const f32x4 ya0 = va[j][0] * ra_ * sc[j][0] + sh[j][0], ya1 = va[j][1] * ra_ * sc[j][1] + sh[j][1], yb0 = vb[j][0] * rb_ * sc[j][0] + sh[j][0], yb1 = vb[j][1] * rb_ * sc[j][1] + sh[j][1];
                oa[lane + 64 * j] = pk8(ya0, ya1); ob[lane + 64 * j] = pk8(yb0, yb1);
                oe[lane + 64 * j] = t ? pk8(ya0 + yb0, ya1 + yb1) : pk8(ya0, ya1);
                oo[lane + 64 * j] = t ? pk8(ya0 - yb0, ya1 - yb1) : pk8(z4, z4); }
        }
    }
}
__device__ __forceinline__ void nyq_phase(const bf16* H, const bf16* WfT, float* nyq, int gw, int NGW, int lane) {
    for (int ch = gw; ch < 1024; ch += NGW) {
        const v4u* wp = (const v4u*)(WfT + (size_t)ch * DM) + lane; v4u wv[4];
#pragma unroll
        for (int j = 0; j < 4; ++j) wv[j] = wp[64 * j];
#pragma unroll
        for (int b = 0; b < 4; ++b) { const v4u* hp = (const v4u*)(H + (size_t)(b * SEQ + SEQ / 2) * DM) + lane; float s = 0.f;
#pragma unroll
            for (int j = 0; j < 4; ++j) { const v4u hv = hp[64 * j];
#pragma unroll
                for (int e = 0; e < 4; ++e) s += bflo(wv[j][e]) * bflo(hv[e]) + bfhi(wv[j][e]) * bfhi(hv[e]); }
            s = wave_sum(s); if (lane == 0) nyq[b * 1024 + ch] = s; }
    }
}
__device__ __forceinline__ void quarter_row_phase(const bf16* UTEe, const bf16* UTOo, float* yE, float* yO, int gw, int NGW, int lane) {
    for (int r = gw; r < 4096; r += NGW) { const v4u* pe = (const v4u*)(UTEe + (size_t)r * 1024) + lane; const v4u* po = (const v4u*)(UTOo + (size_t)r * 1024) + lane; float se = 0.f, so = 0.f;
#pragma unroll
        for (int q = 0; q < 2; ++q) { const v4u ve = pe[64 * q], vo = po[64 * q];
#pragma unroll
            for (int e = 0; e < 4; ++e) { se += bflo(ve[e]) - bfhi(ve[e]); so += bflo(vo[e]) - bfhi(vo[e]); } }
        se = wave_sum(se); so = wave_sum(so); if (lane == 0) { yE[r] = se * (1.f / 64.f); yO[r] = so * (1.f / 64.f); } }
}
__device__ __forceinline__ void ld16(const float* p, f32x4 (&v)[4]) { v[0] = ((const f32x4*)p)[0]; v[1] = ((const f32x4*)p)[1]; v[2] = ((const f32x4*)p)[2]; v[3] = ((const f32x4*)p)[3]; }
__device__ __forceinline__ void st_row_norm(bf16* Y, int row, int lane, const f32x4 (&y)[4]) {
    float ss = 0.f;
#pragma unroll
    for (int q = 0; q < 4; ++q) ss += (y[q][0] * y[q][0] + y[q][1] * y[q][1]) + (y[q][2] * y[q][2] + y[q][3] * y[q][3]);
    const float rs = 1.f / sqrtf(wave_sum(ss) * (1.f / 1024.f) + EPS);
    v4u* o = (v4u*)(Y + (size_t)row * 2048 + 16 * lane); o[0] = pk8(y[0] * rs, y[1] * rs); o[1] = pk8(y[2] * rs, y[3] * rs);
}
__device__ __forceinline__ void combine_phase(const float* PQ4, const float* nyq, const float* yE, const float* yO, const bf16* OP, const float* LSE, bf16* Y, int gw, int NGW, int lane) {
    for (int t = gw; t < BATCH * 1025; t += NGW) {
        const int b = t / 1025, k = t - b * 1025;
        f32x4 ep[4], op[4], eq[4], oq[4], n[4];
        const float sg = (k & 1) ? -1.f / 64.f : 1.f / 64.f;
#pragma unroll
        for (int q = 0; q < 4; ++q) n[q] = *(const f32x4*)(nyq + b * 1024 + 16 * lane + 4 * q) * sg;
        if (k < 1024) { const size_t off = (size_t)k * 4096 + b * 1024 + 16 * lane;
            ld16(PQ4 + off, ep); ld16(PQ4 + (size_t)1024 * 4096 + off, op); ld16(PQ4 + (size_t)2 * 1024 * 4096 + off, eq); ld16(PQ4 + (size_t)3 * 1024 * 4096 + off, oq);
        } else {
#pragma unroll
            for (int q = 0; q < 4; ++q) { ep[q] = *(const f32x4*)(yE + b * 1024 + 16 * lane + 4 * q); oq[q] = *(const f32x4*)(yO + b * 1024 + 16 * lane + 4 * q); op[q] = (f32x4){0.f, 0.f, 0.f, 0.f}; eq[q] = op[q]; } }
        f32x4 y[4];
#pragma unroll
        for (int q = 0; q < 4; ++q) y[q] = (ep[q] + op[q]) - (eq[q] + oq[q]) + n[q];
        st_row_norm(Y, b * SEQ + k, lane, y);
        if (k > 0) {
#pragma unroll
            for (int q = 0; q < 4; ++q) y[q] = (ep[q] + op[q]) + (eq[q] + oq[q]) + n[q];
            st_row_norm(Y, b * SEQ + SEQ - k, lane, y); }
        if (k < 1024) {
#pragma unroll
            for (int q = 0; q < 4; ++q) y[q] = (ep[q] - op[q]) - (oq[q] - eq[q]) + n[q];
            st_row_norm(Y, b * SEQ + SEQ / 2 - k, lane, y); }
        if (k > 0 && k < 1024) {
#pragma unroll
            for (int q = 0; q < 4; ++q) y[q] = (ep[q] - op[q]) + (oq[q] - eq[q]) + n[q];
            st_row_norm(Y, b * SEQ + SEQ / 2 + k, lane, y); }
    }
    for (int tok = gw; tok < M; tok += NGW) {
        const int h = lane >> 3;
        float l0 = LSE[(size_t)tok * 8 + h], l1 = LSE[(size_t)M * 8 + (size_t)tok * 8 + h], l2 = LSE[(size_t)2 * M * 8 + (size_t)tok * 8 + h];
        const v4u* a = (const v4u*)(OP + (size_t)tok * 1024 + 16 * lane); const v4u* bq = (const v4u*)(OP + (size_t)M * 1024 + (size_t)tok * 1024 + 16 * lane); const v4u* cq = (const v4u*)(OP + (size_t)2 * M * 1024 + (size_t)tok * 1024 + 16 * lane);
        const v4u a0 = a[0], a1 = a[1], b0 = bq[0], b1 = bq[1], c0 = cq[0], c1 = cq[1];
        const float lm = fmaxf(l0, fmaxf(l1, l2)); l0 = __builtin_amdgcn_exp2f(l0 - lm); l1 = __builtin_amdgcn_exp2f(l1 - lm); l2 = __builtin_amdgcn_exp2f(l2 - lm);
        const float iw = 1.f / (l0 + l1 + l2); l0 *= iw; l1 *= iw; l2 *= iw;
        float y[16]; float ss = 0.f;
#pragma unroll
        for (int j = 0; j < 4; ++j) { y[2 * j] = l0 * bflo(a0[j]) + l1 * bflo(b0[j]) + l2 * bflo(c0[j]); y[2 * j + 1] = l0 * bfhi(a0[j]) + l1 * bfhi(b0[j]) + l2 * bfhi(c0[j]);
            y[8 + 2 * j] = l0 * bflo(a1[j]) + l1 * bflo(b1[j]) + l2 * bflo(c1[j]); y[8 + 2 * j + 1] = l0 * bfhi(a1[j]) + l1 * bfhi(b1[j]) + l2 * bfhi(c1[j]); }
#pragma unroll
        for (int j = 0; j < 16; ++j) ss += y[j] * y[j];
        const float rs = 1.f / sqrtf(wave_sum(ss) * (1.f / 1024.f) + EPS);
        v4u o0, o1; o0.x = pk2(y[0] * rs, y[1] * rs); o0.y = pk2(y[2] * rs, y[3] * rs); o0.z = pk2(y[4] * rs, y[5] * rs); o0.w = pk2(y[6] * rs, y[7] * rs);
        o1.x = pk2(y[8] * rs, y[9] * rs); o1.y = pk2(y[10] * rs, y[11] * rs); o1.z = pk2(y[12] * rs, y[13] * rs); o1.w = pk2(y[14] * rs, y[15] * rs);
        v4u* o = (v4u*)(Y + (size_t)tok * 2048 + 1024 + 16 * lane); o[0] = o0; o[1] = o1;
    }
}
__device__ __forceinline__ void final_norm_phase(const bf16* x, const float* gain, float* out, int gw, int NGW, int lane) {
    f32x4 gv[4][2];
#pragma unroll
    for (int j = 0; j < 4; ++j)
#pragma unroll
        for (int q = 0; q < 2; ++q) gv[j][q] = ((const f32x4*)gain)[2 * (lane + 64 * j) + q];
    for (int row = gw; row < M; row += NGW) {
        const bf16* xr = x + (size_t)row * DM; f32x4 v[4][2]; float s = 0.f;
#pragma unroll
        for (int j = 0; j < 4; ++j) ld_row8<0>(xr, lane, j, v[j][0], v[j][1]);
#pragma unroll
        for (int j = 0; j < 4; ++j) s += ssq8(v[j][0], v[j][1]);
        const float rstd = 1.f / sqrtf(wave_sum(s) * (1.f / DM) + EPS);
        f32x4* o = (f32x4*)(out + (size_t)row * DM);
#pragma unroll
        for (int j = 0; j < 4; ++j) { o[2 * (lane + 64 * j)] = v[j][0] * rstd * gv[j][0]; o[2 * (lane + 64 * j) + 1] = v[j][1] * rstd * gv[j][1]; }
    }
}

__device__ __forceinline__ int crow(int i, int hi) { return (i & 3) + 8 * (i >> 2) + 4 * hi; }
__device__ __forceinline__ unsigned voff(unsigned row, unsigned ch) { return 256u * row + 16u * (ch ^ (((row & 3u) << 2) | ((row >> 2) & 3u))); }
__device__ __forceinline__ s16x4 vtr(const LAS unsigned char* p) { return __builtin_bit_cast(s16x4, __builtin_amdgcn_ds_read_tr16_b64_v4i16((LAS s16x4*)p)); }
__device__ __forceinline__ void attn_chain(LAS unsigned char* lds, const bf16* Qb, const bf16* Kb, const bf16* Vb, bf16* Ob, float* lseb, int g0, int wave, int lane) {
    constexpr int NJOB = 6, NKB = 8 * NJOB + 4, NSTEP = 5 * NJOB + 4;
    const int r32 = lane & 31, hi = lane >> 5;
    const unsigned blk = (lane >> 4) & 1, tq = (lane & 15) >> 2, tp = lane & 3;
    const int prow = 4 * wave + (lane >> 4);
    const int ksrc = (lane & 15) ^ (prow & 15);
    const int vsrc = (lane & 15) ^ (((prow & 3) << 2) | ((prow >> 2) & 3));
    const int cw = (5 * wave) >> 3;
    const unsigned kbl = 256u * r32 + 16u * ((8u * hi) ^ (r32 & 15));
    unsigned trb[4][2];
#pragma unroll
    for (int d = 0; d < 4; ++d)
#pragma unroll
        for (int t2 = 0; t2 < 2; ++t2) trb[d][t2] = voff(8 * t2 + 4 * hi + tq, 4 * d + 2 * blk + (tp >> 1)) + 8 * (tp & 1);
#define AC_MAP(g_, p_, dil_, res_, loc_) const int p_ = (g_) >> 7, sh##p_ = 7 - 2 * p_, dil_ = 1 << (2 * p_), res_ = ((g_) & 127) >> sh##p_, loc_ = (g_) & ((1 << sh##p_) - 1)
#define AC_ISSUE(kk_) do { int u_ = g0 + (kk_) - 2; u_ = u_ < 0 ? 0 : (u_ > 383 ? 383 : u_); AC_MAP(u_, pu_, du_, ru_, lu_); \
    const size_t rowoff_ = (size_t)(ru_ + du_ * (32 * lu_ + prow)) * 1024; \
    LAS unsigned char* sl_ = lds + ((kk_) & 7) * 16384 + wave * 1024; \
    __builtin_amdgcn_global_load_lds((const unsigned*)(Kb + rowoff_ + 8 * ksrc), (LAS unsigned*)sl_, 16, 0, 0); \
    __builtin_amdgcn_global_load_lds((const unsigned*)(Vb + rowoff_ + 8 * vsrc), (LAS unsigned*)(sl_ + 8192), 16, 0, 0); } while (0)
#define AC_QLOAD(n_) do { const int gq_ = g0 + wave + 8 * (n_); AC_MAP(gq_, pq_, dq_, rq_, lq_); \
    const bf16* qp_ = Qb + (size_t)(rq_ + dq_ * (32 * lq_ + r32)) * 1024 + 64 * hi; \
    _Pragma("unroll") for (int s_ = 0; s_ < 8; ++s_) asm volatile("global_load_dwordx4 %0, %1, off" : "=v"(qn[s_]) : "v"(qp_ + 8 * s_) : "memory"); } while (0)
#define AC_FINALIZE(n_) do { const int gq_ = g0 + wave + 8 * (n_); AC_MAP(gq_, pq_, dq_, rq_, lq_); \
    const int qpos = rq_ + dq_ * (32 * lq_ + r32); \
    const float lt = l_run + shfl_xor_f(l_run, 32), inv = 1.f / lt; \
    bf16* op = Ob + (size_t)pq_ * M * 1024 + (size_t)qpos * 1024 + 8 * hi; \
    _Pragma("unroll") \
    for (int d = 0; d < 4; ++d) \
    _Pragma("unroll") \
    for (int j2 = 0; j2 < 2; ++j2) {   \
        unsigned a0 = pk2(o[d][8 * j2] * inv, o[d][8 * j2 + 1] * inv), a1 = pk2(o[d][8 * j2 + 2] * inv, o[d][8 * j2 + 3] * inv); \
        unsigned b0 = pk2(o[d][8 * j2 + 4] * inv, o[d][8 * j2 + 5] * inv), b1 = pk2(o[d][8 * j2 + 6] * inv, o[d][8 * j2 + 7] * inv); \
        const auto r0_ = __builtin_amdgcn_permlane32_swap(a0, b0, false, false); const auto r1_ = __builtin_amdgcn_permlane32_swap(a1, b1, false, false); \
        v4u w; w.x = r0_[0]; w.y = r1_[0]; w.z = r0_[1]; w.w = r1_[1]; \
        *(v4u*)(op + 32 * d + 16 * j2) = w; } \
    if (hi == 0) lseb[(size_t)pq_ * M * 8 + (size_t)qpos * 8] = m_run + log2f(lt); \
    m_run = -1e30f; l_run = 0.f; \
    _Pragma("unroll") for (int d = 0; d < 4; ++d) _Pragma("unroll") for (int i = 0; i < 16; ++i) o[d][i] = 0.f; } while (0)
    f32x16 o[4]; float m_run = -1e30f, l_run = 0.f; bf16x8 qf[8], qn[8];
    AC_QLOAD(0);
    AC_ISSUE(0); AC_ISSUE(1); AC_ISSUE(2); AC_ISSUE(3);
#pragma unroll
    for (int d = 0; d < 4; ++d)
#pragma unroll
        for (int i = 0; i < 16; ++i) o[d][i] = 0.f;
    int p1 = 4;
    int ph = 0, mm = 0;
    for (int s = 0; s < NSTEP; ++s) {
        const int rel = s - cw; const bool act = rel >= 0 && rel < 5 * NJOB;
        const int n = act ? rel / 5 : 0, t = act ? rel - 5 * n : 3;
        { const int y = p1 + ((act && n > 0 && (t == 1 || t == 2)) ? 9 : (act && t == 4 && n + 1 < NJOB) ? 8 : 0);
          if (y == 2) asm volatile("s_waitcnt vmcnt(2) lgkmcnt(0)" ::: "memory");
          else if (y == 4) asm volatile("s_waitcnt vmcnt(4) lgkmcnt(0)" ::: "memory");
          else if (y == 8) asm volatile("s_waitcnt vmcnt(8) lgkmcnt(0)" ::: "memory");
          else if (y == 10) asm volatile("s_waitcnt vmcnt(10) lgkmcnt(0)" ::: "memory");
          else if (y == 12) asm volatile("s_waitcnt vmcnt(12) lgkmcnt(0)" ::: "memory");
          else if (y == 9) asm volatile("s_waitcnt vmcnt(9) lgkmcnt(0)" ::: "memory");
          else if (y == 11) asm volatile("s_waitcnt vmcnt(11) lgkmcnt(0)" ::: "memory");
          else if (y == 13) asm volatile("s_waitcnt vmcnt(13) lgkmcnt(0)" ::: "memory");
          else asm volatile("s_waitcnt vmcnt(0) lgkmcnt(0)" ::: "memory"); }
        if (act && t == 0) {
            asm volatile("" : "+v"(qn[0]), "+v"(qn[1]), "+v"(qn[2]), "+v"(qn[3]), "+v"(qn[4]), "+v"(qn[5]), "+v"(qn[6]), "+v"(qn[7]));
#pragma unroll
            for (int s2 = 0; s2 < 8; ++s2) qf[s2] = qn[s2];
        }
        __builtin_amdgcn_s_barrier();
        asm volatile("" ::: "memory");
        { int k0, k1 = -1;
          if (ph == 0) k0 = 8 * mm + 4; else if (ph == 1) { k0 = 8 * mm + 5; k1 = k0 + 1; } else if (ph == 2) k0 = 8 * mm + 7; else if (ph == 3) { k0 = 8 * mm + 8; k1 = k0 + 1; } else { k0 = 8 * mm + 10; k1 = k0 + 1; }
          p1 = 0;
          if (k0 < NKB) { AC_ISSUE(k0); p1 = 2; }
          if (k1 >= 0 && k1 < NKB) { AC_ISSUE(k1); p1 += 2; } }
        if (++ph == 5) { ph = 0; ++mm; }
        if (act && t == 3 && n + 1 < NJOB) AC_QLOAD(n + 1);
        if (act) {
            if (t == 0 && n > 0) AC_FINALIZE(n - 1);
            const int L = wave + 8 * n, kk = L + t, gq = g0 + L, gk = gq - 2 + t;
            AC_MAP(gq, pq, dq, rq, lq);
            const bool valid = gk >= 0 && gk < 384 && (gk >> 7) == pq && (((gk & 127) >> shpq) == rq);
            (void)dq; (void)lq;
            if (valid) {
                const unsigned kb_ = kbl + (unsigned)(kk & 7) * 16384u;
                bf16x8 kf[8];
#pragma unroll
                for (int s2 = 0; s2 < 8; ++s2) kf[s2] = *(const LAS bf16x8*)(lds + (kb_ ^ ((unsigned)s2 << 4)));
                f32x16 sa;
#pragma unroll
                for (int i = 0; i < 16; ++i) sa[i] = 0.f;
                __builtin_amdgcn_sched_barrier(0); asm volatile("s_waitcnt lgkmcnt(0)" ::: "memory"); __builtin_amdgcn_sched_barrier(0);
#pragma unroll
                for (int s2 = 0; s2 < 8; ++s2) sa = __builtin_amdgcn_mfma_f32_32x32x16_bf16(kf[s2], qf[s2], sa, 0, 0, 0);
                if (t == 0 || t == 4) { const int dbase = 32 * t + 4 * hi - r32;
#pragma unroll
                  for (int i = 0; i < 16; ++i) if ((unsigned)(dbase + (i & 3) + 8 * (i >> 2)) > 128u) sa[i] = -1e30f; }
                float pmax = sa[0];
#pragma unroll
                for (int i = 1; i < 16; ++i) pmax = fmaxf(pmax, sa[i]);
                pmax = fmaxf(pmax, shfl_xor_f(pmax, 32));
                const float mn = fmaxf(m_run, pmax), alpha = __builtin_amdgcn_exp2f(m_run - mn); m_run = mn;
                float ps = 0.f;
#pragma unroll
                for (int i = 0; i < 16; ++i) { sa[i] = __builtin_amdgcn_exp2f(sa[i] - mn); ps += sa[i]; }
                l_run = l_run * alpha + ps;
#pragma unroll
                for (int d = 0; d < 4; ++d)
#pragma unroll
                    for (int i = 0; i < 16; ++i) o[d][i] *= alpha;
                bf16x8 pa[2];
#pragma unroll
                for (int s2 = 0; s2 < 2; ++s2) { v4u w; w.x = pk2(sa[8 * s2], sa[8 * s2 + 1]); w.y = pk2(sa[8 * s2 + 2], sa[8 * s2 + 3]); w.z = pk2(sa[8 * s2 + 4], sa[8 * s2 + 5]); w.w = pk2(sa[8 * s2 + 6], sa[8 * s2 + 7]);
                    pa[s2] = __builtin_bit_cast(bf16x8, w); }
                const unsigned so_ = (unsigned)(uintptr_t)lds + (unsigned)(kk & 7) * 16384u + 8192u;
                s16x4 lo[2][4], hh[2][4];
#pragma unroll
                for (int d = 0; d < 4; ++d) { const unsigned a0_ = trb[d][0] + so_, a1_ = trb[d][1] + so_;
                    asm volatile("ds_read_b64_tr_b16 %0, %1" : "=&v"(lo[0][d]) : "v"(a0_) : "memory");
                    asm volatile("ds_read_b64_tr_b16 %0, %1" : "=&v"(hh[0][d]) : "v"(a1_) : "memory");
                    asm volatile("ds_read_b64_tr_b16 %0, %1 offset:4096" : "=&v"(lo[1][d]) : "v"(a0_) : "memory");
                    asm volatile("ds_read_b64_tr_b16 %0, %1 offset:4096" : "=&v"(hh[1][d]) : "v"(a1_) : "memory"); }
                asm volatile("s_waitcnt lgkmcnt(0)" ::: "memory"); __builtin_amdgcn_sched_barrier(0);
#pragma unroll
                for (int s2 = 0; s2 < 2; ++s2)
#pragma unroll
                    for (int d = 0; d < 4; ++d) { const bf16x8 vt = {lo[s2][d][0], lo[s2][d][1], lo[s2][d][2], lo[s2][d][3], hh[s2][d][0], hh[s2][d][1], hh[s2][d][2], hh[s2][d][3]};
                        o[d] = __builtin_amdgcn_mfma_f32_32x32x16_bf16(vt, pa[s2], o[d], 0, 0, 0); }
            }
        }
    }
    AC_FINALIZE(NJOB - 1);
    asm volatile("s_waitcnt vmcnt(0) lgkmcnt(0)" ::: "memory");
    __builtin_amdgcn_s_barrier();
    asm volatile("" ::: "memory");
#undef AC_MAP
#undef AC_ISSUE
#undef AC_QLOAD
#undef AC_FINALIZE
}
__device__ __forceinline__ void attn_phase(LAS unsigned char* lds, const bf16* Q, const bf16* K, const bf16* V, bf16* OP, float* LSE, int wave, int lane, int bx, int G) {
    for (int item = bx; item < 256; item += G) {
        const int xg = item & 7, lw = item >> 3, bh = 4 * xg + (lw >> 3), b = bh >> 3, h = bh & 7, cseg = lw & 7;
        const size_t base = (size_t)b * SEQ * 1024 + h * 128;
        attn_chain(lds, Q + base, K + base, V + base, OP + base, LSE + (size_t)b * SEQ * 8 + h, 48 * cseg, wave, lane);
    }
}

struct Args { const float* in[14]; float* out; unsigned char* ws; };
__global__ void __launch_bounds__(NWAVES * 64, 2) hybrid_fwd(Args args) {
    extern __shared__ __attribute__((aligned(16))) unsigned char lds_raw[];
    LAS unsigned char* lds = (LAS unsigned char*)lds_raw;
    volatile LAS unsigned* MISC = (volatile LAS unsigned*)(lds + MISC_OFF);
    const int tid = threadIdx.x, lane = tid & 63, wave = __builtin_amdgcn_readfirstlane(tid >> 6);
    const int G = gridDim.x; const int bx = blockIdx.x; const int vcu = (G % 8 == 0) ? (bx % 8) * (G / 8) + bx / 8 : bx;
    const int gw = vcu * NWAVES + wave, NGW = G * NWAVES;
    unsigned char* ws = args.ws;
    gu32* ctl = (gu32*)(ws + WS_CTL);
    for (int u = tid; u < (LDS_BYTES - LDSCTL_OFF) / 4; u += NWAVES * 64) ((LAS unsigned*)(lds + LDSCTL_OFF))[u] = 0u;
    __syncthreads();
    XcdBarrier bar = xcd_barrier_post((unsigned*)(ctl + CW_BAR), MISC + 8); bar.wv = wave;
#define GRID_BAR() do { XcdBarrier b2_ = bar; b2_.x = xb_xcc_id(); { unsigned zb_ = 0u; asm volatile("" : "+s"(zb_)); b2_.bar = bar.bar + zb_; } xcd_barrier(b2_); } while (0)

    p0_mod(lds, args.in[1], args.in[2], args.in[3], (float*)(ws + WS_MOD), tid, wave, lane, G);
    p0_fold(lds, args.in[6], args.in[7], ws + WS_W, tid, G);
    p0_dmat(lds, (bf16*)(ws + WS_DMAT), tid, G);
    p0_weights(lds, args.in, ws + WS_W, gw, NGW, wave, lane);
    p0_rope((float*)(ws + WS_ROPE), (float*)(ws + WS_ROPE) + 4096 * 64, gw * 64 + lane, NGW * 64);
    GRID_BAR();

    for (int l = 0; l < 2; ++l) {
        unsigned zo_ = 0u; asm volatile("" : "+s"(zo_));
        unsigned char* wsl = args.ws + zo_;
        const int lane = xb_lane();
        int bxl = blockIdx.x, Gl = gridDim.x; asm volatile("" : "+s"(bxl), "+s"(Gl));
        const int bx = bxl, G = Gl, vcu = (G % 8 == 0) ? (bx % 8) * (G / 8) + bx / 8 : bx, gw = vcu * NWAVES + wave, NGW = G * NWAVES;
        float* mod = (float*)(wsl + WS_MOD);
        float* rc = (float*)(wsl + WS_ROPE); float* rsn = rc + 4096 * 64;
        float* LSE = (float*)(wsl + WS_LSE);
        bf16* Dm = (bf16*)(wsl + WS_DMAT); bf16* HE = (bf16*)(wsl + WS_HE); bf16* HO = (bf16*)(wsl + WS_HO); float* nyq = (float*)(wsl + WS_NYQ); float* yN = (float*)(wsl + WS_YN); float* PQ = (float*)(wsl + WS_ACT);
        bf16* X = (bf16*)(wsl + WS_X); bf16* H = (bf16*)(wsl + WS_H); bf16* ACT = (bf16*)(wsl + WS_ACT); bf16* UT = (bf16*)(wsl + WS_UT);
        bf16* Qb = (bf16*)(wsl + WS_Q); bf16* Kb = (bf16*)(wsl + WS_K); bf16* Vb = (bf16*)(wsl + WS_V); bf16* YF = (bf16*)(wsl + WS_YF); bf16* OP = (bf16*)(wsl + WS_OP);
        const float* modl = mod + (size_t)l * 4 * MODW;
        unsigned char* wl = wsl + WS_W + (size_t)l * W_LAYER;
        if (l == 0) norm_mod_phase<1>(args.in[0], modl, 0, 1, H, gw, NGW, xb_lane()); else norm_mod_phase<0>(X, modl, 0, 1, H, gw, NGW, xb_lane());
        GRID_BAR();
        { pg8::Gemm g{H, (const bf16*)(wl + W_GU1), M, 2 * FF, DM}; pg8::StaticOrderT<M, 2 * FF> S; S.init(G, bx);
          EpiSwiGLU E{ACT}; pg8::gemm_phase<EpiSwiGLU, pg8::StaticOrderT<M, 2 * FF>, true, true, DM>(lds, g, S, E, wave); }
        GRID_BAR();
        { pg8::Gemm g{ACT + (FF - 64), (const bf16*)(wl + W_D1) + (FF - 64), M, DM, FF}; pg8::StaticOrderT<M, DM, 4> S; S.init(G, bx);
          if (l == 0) { EpiResid<0, 1, 1> E{args.in[0], X, modl + 2 * DM, nullptr}; pg8::gemm_phase<EpiResid<0, 1, 1>, pg8::StaticOrderT<M, DM, 4>, true, true, FF, true>(lds, g, S, E, wave); }
          else { EpiResid<0, 1, 0> E{X, X, modl + 2 * DM, nullptr}; pg8::gemm_phase<EpiResid<0, 1, 0>, pg8::StaticOrderT<M, DM, 4>, true, true, FF, true>(lds, g, S, E, wave); } }
        GRID_BAR();
        norm_mod_fold_phase(X, modl, 3, 4, H, HE, HO, gw, NGW, xb_lane());
        GRID_BAR();
        { pg8::Gemm g{(const bf16*)(wl + W_F), HE, 1024, 8192, DM}; pg8::StaticOrderT<1024, 8192> S; S.init(G, bx);
          EpiUT E{UT}; pg8::gemm_phase<EpiUT, pg8::StaticOrderT<1024, 8192>, true, true, DM>(lds, g, S, E, wave); }
        { pg8::Gemm g{(const bf16*)(wl + W_F) + (size_t)1024 * DM, HO, 1024, 8192, DM}; pg8::StaticOrderT<1024, 8192> S; S.init(G, (bx + G / 2) % G);
          EpiUT E{UT + (size_t)2 * 4096 * 1024}; pg8::gemm_phase<EpiUT, pg8::StaticOrderT<1024, 8192>, true, true, DM>(lds, g, S, E, wave); }
        nyq_phase(H, (const bf16*)(wl + W_F), nyq, gw, NGW, xb_lane());
        { pg8::Gemm g{H, (const bf16*)(wl + W_QKV), M, 3072, DM}; pg8::StaticOrderT<M, 3072, 4> S; S.init(G, bx);
          EpiQKV E{Qb, Kb, Vb, rc, rsn}; pg8::gemm_phase<EpiQKV, pg8::StaticOrderT<M, 3072, 4>, true, true, DM>(lds, g, S, E, wave); }
        GRID_BAR();
#ifndef ATTN_REP
#define ATTN_REP 1
#endif
        for (int rep_ = 0; rep_ < ATTN_REP; ++rep_)
        attn_phase(lds, Qb, Kb, Vb, OP, LSE, wave, xb_lane(), bx, G);
        for (int mq = 0; mq < 4; ++mq) {
            pg8::Gemm g{Dm + (size_t)mq * 1024 * 1024, UT + (size_t)mq * 4096 * 1024, 1024, 4096, 1024}; pg8::StaticOrderT<1024, 4096> S; S.init(G, (bx + G - (G / 4) * mq) % G);
            EpiPQ E{PQ + (size_t)mq * 1024 * 4096}; pg8::gemm_phase<EpiPQ, pg8::StaticOrderT<1024, 4096>, true, true, 1024>(lds, g, S, E, wave); }
        quarter_row_phase(UT, UT + (size_t)3 * 4096 * 1024, yN, yN + 4096, gw, NGW, xb_lane());
        GRID_BAR();
        combine_phase(PQ, nyq, yN, yN + 4096, OP, LSE, YF, gw, NGW, xb_lane());
        GRID_BAR();
        { pg8::Gemm g{YF, (const bf16*)(wl + W_OF), M, DM, DM}; pg8::StaticOrderT<M, DM, 4> S; S.init(G, bx);
          EpiResid<0, 0, 0> E{X, X, modl + 5 * DM, nullptr}; pg8::gemm_phase<EpiResid<0, 0, 0>, pg8::StaticOrderT<M, DM, 4>, true, true, DM>(lds, g, S, E, wave); }
        GRID_BAR();
        norm_mod_phase<0>(X, modl, 6, 7, H, gw, NGW, xb_lane());
        GRID_BAR();
        { pg8::Gemm g{H, (const bf16*)(wl + W_GU2), M, 2 * FF, DM}; pg8::StaticOrderT<M, 2 * FF> S; S.init(G, bx);
          EpiSwiGLU E{ACT}; pg8::gemm_phase<EpiSwiGLU, pg8::StaticOrderT<M, 2 * FF>, true, true, DM>(lds, g, S, E, wave); }
        GRID_BAR();
        { pg8::Gemm g{ACT + (FF - 64), (const bf16*)(wl + W_D2) + (FF - 64), M, DM, FF}; pg8::StaticOrderT<M, DM, 4> S; S.init(G, bx);
          EpiResid<0, 1, 0> E{X, X, modl + 8 * DM, nullptr}; pg8::gemm_phase<EpiResid<0, 1, 0>, pg8::StaticOrderT<M, DM, 4>, true, true, FF, true>(lds, g, S, E, wave); }
        GRID_BAR();
    }
    { const int lane_f = xb_lane(); asm volatile("" ::: "memory");
      final_norm_phase((const bf16*)(ws + WS_X), args.in[13], args.out, gw, NGW, lane_f); }
}

extern "C" void kernel_launch(void* const* d_in, const int* in_sizes, int n_in, void* d_out, int out_size, void* d_ws, size_t ws_size, hipStream_t stream) {
    static int grid = 0;
    if (grid == 0) {
        if (n_in != 14 || in_sizes[0] != M * DM || out_size != M * DM || ws_size < WS_END) { fprintf(stderr, "kernel_launch: shape mismatch (n_in %d in0 %d out %d ws %zu, need ws >= %zu)\n", n_in, n_in > 0 ? in_sizes[0] : -1, out_size, ws_size, (size_t)WS_END); grid = -1; return; }
        int dev = 0, cus = 0, per_cu = 0;
        if (hipGetDevice(&dev) != hipSuccess || hipDeviceGetAttribute(&cus, hipDeviceAttributeMultiprocessorCount, dev) != hipSuccess) { fprintf(stderr, "kernel_launch: device query failed\n"); grid = -1; return; }
        if (hipFuncSetAttribute((const void*)hybrid_fwd, hipFuncAttributeMaxDynamicSharedMemorySize, LDS_BYTES) != hipSuccess) { fprintf(stderr, "kernel_launch: hipFuncSetAttribute failed\n"); grid = -1; return; }
        if (hipOccupancyMaxActiveBlocksPerMultiprocessor(&per_cu, (const void*)hybrid_fwd, NWAVES * 64, LDS_BYTES) != hipSuccess || per_cu < 1) { fprintf(stderr, "kernel_launch: occupancy query reports %d workgroups per CU\n", per_cu); }
        (void)hipGetLastError();
        grid = cus;
    }
    if (grid < 0) return;
    if (hipMemsetAsync((char*)d_ws + WS_CTL, 0, CTL_ZERO_BYTES, stream) != hipSuccess) { fprintf(stderr, "kernel_launch: memset failed\n"); return; }
    Args a{};
    for (int i = 0; i < 14; ++i) a.in[i] = (const float*)d_in[i];
    a.out = (float*)d_out; a.ws = (unsigned char*)d_ws;
    hipLaunchKernelGGL(hybrid_fwd, dim3(grid), dim3(NWAVES * 64), LDS_BYTES, stream, a);
    const hipError_t le = hipPeekAtLastError();
    if (le != hipSuccess) fprintf(stderr, "kernel_launch: launch failed: %s\n", hipGetErrorName(le));
}
```

```cpp
#include <hip/hip_runtime.h>
#include <cstdio>
#include <cstdint>
namespace pg8 {
#define PG8_LAS __attribute__((address_space(3)))
typedef unsigned short bf16_t;
typedef short bf16x8 __attribute__((ext_vector_type(8)));
typedef float f32x4 __attribute__((ext_vector_type(4)));
typedef unsigned u32x4 __attribute__((ext_vector_type(4)));
constexpr int BM = 256, BK = 64, HALF = 128, HTB = HALF * BK * 2  , STAGE_BYTES = 8 * HTB, NXCD = 8, WGM = 8;

__host__ __device__ __forceinline__ int lds_byte(int r, int c) { const int st = (r >> 4) * 2 + (c >> 5), rr = r & 15, cc = c & 31, ob = rr * 64 + cc * 2; return st * 1024 + (ob ^ (((ob >> 9) & 1) << 5)); }
__host__ __device__ __forceinline__ void stage_rc(int b, int& R, int& C) { const int st = b / 1024, sb = b % 1024, swz = sb ^ (((sb >> 9) & 1) << 5); R = (st >> 1) * 16 + swz / 64; C = (st & 1) * 32 + (swz % 64) / 2; }
__host__ __device__ __forceinline__ int perm32(int rho) { const int n = rho >> 4, i = rho & 15; return 8 * (i >> 2) + 4 * n + (i & 3); }

struct Unit { int pm, pn; };
struct Gemm { const bf16_t* A; const bf16_t* Bt; int M, N, K; };

struct StaticOrder {
    int nM, nN, nwg, G, c;
    __host__ __device__ void init(int M, int N, int G_, int c_) { nM = M / BM; nN = N / BM; nwg = nM * nN; G = G_; c = c_; }
    __host__ __device__ bool next(int i, Unit& u) const {
        const long L = (long)i * G + c; if (L >= nwg) return false;
        int wgid = (int)L; { const int q = nwg / NXCD, r = nwg % NXCD, xcd = wgid % NXCD, off = wgid / NXCD; wgid = (xcd < r ? xcd * (q + 1) : r * (q + 1) + (xcd - r) * q) + off; }
        const int nig = WGM * nN, gid = wgid / nig, fm = gid * WGM, gsz = (nM - fm) < WGM ? (nM - fm) : WGM;
        u.pm = fm + ((wgid % nig) % gsz); u.pn = (wgid % nig) / gsz; return true;
    }
    __device__ __forceinline__ void a_ready(const Unit&) const {}
    __device__ __forceinline__ void done(const Unit&) const {}
};

template <int MC, int NC, int WG = WGM> struct StaticOrderT {
    static constexpr int nM = MC / BM, nN = NC / BM, nwg = nM * nN;
    int G, c;
    __host__ __device__ void init(int G_, int c_) { G = G_; c = c_; }
    __host__ __device__ bool next(int i, Unit& u) const {
        const long L = (long)i * G + c; if (L >= nwg) return false;
        int wgid = (int)L; { constexpr int q = nwg / NXCD, r = nwg % NXCD; const int xcd = wgid % NXCD, off = wgid / NXCD; wgid = (xcd < r ? xcd * (q + 1) : r * (q + 1) + (xcd - r) * q) + off; }
        constexpr int nig = WG * nN; const int gid = wgid / nig, fm = gid * WG, gsz = (nM - fm) < WG ? (nM - fm) : WG;
        u.pm = fm + ((wgid % nig) % gsz); u.pn = (wgid % nig) / gsz; return true;
    }
    __device__ __forceinline__ void a_ready(const Unit&) const {}
    __device__ __forceinline__ void done(const Unit&) const {}
};
__device__ __forceinline__ unsigned cvt_pk_bf16(float lo, float hi) { unsigned r; asm volatile("v_cvt_pk_bf16_f32 %0, %1, %2" : "=v"(r) : "v"(lo), "v"(hi)); return r; }
template <class Epi, class Sched, bool ALIGN_EPI = false, bool SP2 = false, int KC = 0, bool KREV = false>
__device__ __forceinline__ void gemm_phase(PG8_LAS unsigned char* lds, const Gemm g, const Sched& S, const Epi& E, const int wave_id) {
    int tid_; asm volatile("v_mbcnt_lo_u32_b32 %0, -1, 0\n\tv_mbcnt_hi_u32_b32 %0, -1, %0" : "=v"(tid_)); tid_ += 64 * wave_id;
    const int tid = tid_, wid = __builtin_amdgcn_readfirstlane(tid >> 6), lane = tid & 63, wr = wid >> 2, wc = wid & 3, fr = lane & 15, fq = lane >> 4;
    const int K = KC ? KC : g.K, nt = K / BK;
    unsigned voffA[2], voffB[2];
#pragma unroll
    for (int i = 0; i < 2; ++i) { int R, C; stage_rc(tid * 16 + i * 8192, R, C); const int Rb = Epi::PERM ? ((R & ~31) + perm32(R & 31)) : R;
        voffA[i] = (unsigned)(R * K + C) * 2u; voffB[i] = (unsigned)(Rb * K + C) * 2u; }
    const size_t kstep = (size_t)(BK * 2);
#define PG8_KADV(p, n) (KREV ? (p) - (n) : (p) + (n))
    const size_t hstep = (size_t)HALF * K * 2;
    const size_t tstep = 2 * hstep;
    const unsigned ldsw = (unsigned)wid * 1024u;
    const int aoff = lds_byte(wr * 64 + fr, fq * 8), boff = lds_byte(wc * 32 + fr, fq * 8);
#define PG8_SA(b, h) (((b) * 2 + (h)) * HTB)
#define PG8_SB(b, h) ((4 + (b) * 2 + (h)) * HTB)
#define PG8_STAGE(bufoff, gbase, voff) do { _Pragma("unroll") for (int _i = 0; _i < 2; ++_i) \
        __builtin_amdgcn_global_load_lds((const unsigned*)((const char*)(gbase) + (voff)[_i]), (PG8_LAS unsigned*)(lds + (bufoff) + ldsw + _i * 8192), 16, 0, 0); } while (0)
#define PG8_LDA(dst, b, h) do { _Pragma("unroll") for (int m = 0; m < 4; ++m) _Pragma("unroll") for (int k = 0; k < 2; ++k) dst[m][k] = *(const PG8_LAS bf16x8*)(lds + PG8_SA(b, h) + aoff + m * 2048 + k * 1024); } while (0)
#define PG8_LDB(dst, b, h) do { _Pragma("unroll") for (int n = 0; n < 2; ++n) _Pragma("unroll") for (int k = 0; k < 2; ++k) dst[n][k] = *(const PG8_LAS bf16x8*)(lds + PG8_SB(b, h) + boff + n * 2048 + k * 1024); } while (0)
#define PG8_MMA(ai, bj, At, Bt) do { __builtin_amdgcn_s_setprio(1); _Pragma("unroll") for (int m = 0; m < 4; ++m) _Pragma("unroll") for (int n = 0; n < 2; ++n) _Pragma("unroll") for (int k = 0; k < 2; ++k) \
        acc[ai][bj][m][n] = __builtin_amdgcn_mfma_f32_16x16x32_bf16(Bt[n][k], At[m][k], acc[ai][bj][m][n], 0, 0, 0); __builtin_amdgcn_s_setprio(0); } while (0)
#define PG8_WAIT_V(n) asm volatile("s_waitcnt vmcnt(" #n ")" ::: "memory")
#define PG8_WAIT_L(n) asm volatile("s_waitcnt lgkmcnt(" #n ")" ::: "memory")
#define PG8_BAR __builtin_amdgcn_s_barrier()
#define PG8_SCHED __builtin_amdgcn_sched_barrier(0)
    Unit cur, nxt; int ui = 0;
    if (!S.next(0, cur)) return;
    f32x4 acc[2][2][4][2];
#pragma unroll
    for (int a = 0; a < 2; ++a)
#pragma unroll
        for (int b = 0; b < 2; ++b)
#pragma unroll
            for (int m = 0; m < 4; ++m)
#pragma unroll
                for (int n = 0; n < 2; ++n) acc[a][b][m][n] = (f32x4){0.f, 0.f, 0.f, 0.f};
    bf16x8 At[4][2], B0[2][2], B1[2][2];
    const char* cA = (const char*)g.A + (size_t)cur.pm * tstep; const char* cB = (const char*)g.Bt + (size_t)cur.pn * tstep;
    S.a_ready(cur);
    if constexpr (SP2) {
        PG8_STAGE(PG8_SB(0, 0), cB, voffB); PG8_STAGE(PG8_SB(0, 1), cB + hstep, voffB); PG8_STAGE(PG8_SA(0, 0), cA, voffA); PG8_STAGE(PG8_SA(0, 1), cA + hstep, voffA);
        if (wr == 1) PG8_BAR;
        PG8_WAIT_V(2); PG8_BAR;
        PG8_STAGE(PG8_SB(1, 0), PG8_KADV(cB, kstep), voffB); PG8_STAGE(PG8_SA(1, 0), PG8_KADV(cA, kstep), voffA); PG8_STAGE(PG8_SB(1, 1), PG8_KADV(cB + hstep, kstep), voffB);
        PG8_WAIT_V(6); PG8_BAR;
    } else {
        PG8_STAGE(PG8_SB(0, 0), cB, voffB); PG8_STAGE(PG8_SA(0, 0), cA, voffA); PG8_STAGE(PG8_SB(0, 1), cB + hstep, voffB); PG8_STAGE(PG8_SA(0, 1), cA + hstep, voffA);
        if (wr == 1) PG8_BAR;
        PG8_WAIT_V(4); PG8_BAR;
        PG8_STAGE(PG8_SB(1, 0), PG8_KADV(cB, kstep), voffB); PG8_STAGE(PG8_SA(1, 0), PG8_KADV(cA, kstep), voffA); PG8_STAGE(PG8_SB(1, 1), PG8_KADV(cB + hstep, kstep), voffB);
        PG8_WAIT_V(6); PG8_BAR;
    }
    for (;;) {
        const bool has_next = S.next(ui + 1, nxt);
        const char* nA = has_next ? (const char*)g.A + (size_t)nxt.pm * tstep : cA; const char* nB = has_next ? (const char*)g.Bt + (size_t)nxt.pn * tstep : cB;
        for (int t = 0; t < nt; t += 2) {
            if constexpr (Epi::MIDK) { if (t == nt / 2) E.midk(acc, cur, wr, wc, fr, fq); }
            const bool last = (t == nt - 2);
            const char* a1 = PG8_KADV(cA, (size_t)(t + 1) * kstep);
            const char* a2 = last ? nA : PG8_KADV(cA, (size_t)(t + 2) * kstep); const char* b2 = last ? nB : PG8_KADV(cB, (size_t)(t + 2) * kstep);
            const char* a3 = PG8_KADV(a2, kstep); const char* b3 = PG8_KADV(b2, kstep);
            if (last && has_next) S.a_ready(nxt);
            if constexpr (SP2) {
            PG8_LDB(B0, 0, 0); PG8_LDB(B1, 0, 1); PG8_SCHED; PG8_LDA(At, 0, 0); PG8_STAGE(PG8_SA(1, 1), a1 + hstep, voffA);
            PG8_WAIT_V(8); PG8_WAIT_L(0); PG8_BAR; PG8_MMA(0, 0, At, B0); PG8_MMA(0, 1, At, B1); PG8_BAR; PG8_SCHED;
            PG8_LDA(At, 0, 1); PG8_STAGE(PG8_SB(0, 0), b2, voffB); PG8_STAGE(PG8_SB(0, 1), b2 + hstep, voffB); PG8_STAGE(PG8_SA(0, 0), a2, voffA);
            PG8_WAIT_V(8); PG8_WAIT_L(0); PG8_BAR; PG8_MMA(1, 0, At, B0); PG8_MMA(1, 1, At, B1); PG8_BAR; PG8_SCHED;
            PG8_LDB(B0, 1, 0); PG8_LDB(B1, 1, 1); PG8_SCHED; PG8_LDA(At, 1, 0); PG8_STAGE(PG8_SA(0, 1), a2 + hstep, voffA);
            PG8_WAIT_V(8); PG8_WAIT_L(0); PG8_BAR; PG8_MMA(0, 0, At, B0); PG8_MMA(0, 1, At, B1); PG8_BAR; PG8_SCHED;
            PG8_LDA(At, 1, 1); PG8_STAGE(PG8_SB(1, 0), b3, voffB); PG8_STAGE(PG8_SB(1, 1), b3 + hstep, voffB); PG8_STAGE(PG8_SA(1, 0), a3, voffA);
            PG8_WAIT_V(8); PG8_WAIT_L(0); PG8_BAR; PG8_MMA(1, 0, At, B0); PG8_MMA(1, 1, At, B1); PG8_BAR; PG8_SCHED;
            } else {
            PG8_LDB(B0, 0, 0); PG8_SCHED; PG8_LDA(At, 0, 0); PG8_STAGE(PG8_SA(1, 1), a1 + hstep, voffA);
            PG8_WAIT_L(8); PG8_BAR; PG8_WAIT_L(0); PG8_MMA(0, 0, At, B0); PG8_BAR; PG8_SCHED;
            PG8_LDB(B1, 0, 1); PG8_STAGE(PG8_SB(0, 0), b2, voffB);
            PG8_BAR; PG8_WAIT_L(0); PG8_MMA(0, 1, At, B1); PG8_BAR;
            PG8_LDA(At, 0, 1); PG8_STAGE(PG8_SA(0, 0), a2, voffA);
            PG8_BAR; PG8_WAIT_L(0); PG8_MMA(1, 0, At, B0); PG8_BAR; PG8_SCHED;
            PG8_STAGE(PG8_SB(0, 1), b2 + hstep, voffB);
            PG8_WAIT_V(6); PG8_BAR; PG8_MMA(1, 1, At, B1); PG8_BAR;
            PG8_LDB(B0, 1, 0); PG8_SCHED; PG8_LDA(At, 1, 0); PG8_STAGE(PG8_SA(0, 1), a2 + hstep, voffA);
            PG8_WAIT_L(8); PG8_BAR; PG8_WAIT_L(0); PG8_MMA(0, 0, At, B0); PG8_BAR; PG8_SCHED;
            PG8_LDB(B1, 1, 1); PG8_STAGE(PG8_SB(1, 0), b3, voffB);
            PG8_BAR; PG8_WAIT_L(0); PG8_MMA(0, 1, At, B1); PG8_BAR;
            PG8_LDA(At, 1, 1); PG8_STAGE(PG8_SA(1, 0), a3, voffA);
            PG8_BAR; PG8_WAIT_L(0); PG8_MMA(1, 0, At, B0); PG8_BAR; PG8_SCHED;
            PG8_STAGE(PG8_SB(1, 1), b3 + hstep, voffB);
            PG8_WAIT_V(6); PG8_BAR; PG8_MMA(1, 1, At, B1); PG8_BAR;
            }
        }
        if constexpr (ALIGN_EPI) { if (wr == 0) PG8_BAR; }
        if constexpr (!Epi::AFTER_DRAIN) { E(acc, cur, wr, wc, fr, fq); S.done(cur); }
        if (!has_next) break;
#pragma unroll
        for (int a = 0; a < 2; ++a)
#pragma unroll
            for (int b = 0; b < 2; ++b)
#pragma unroll
                for (int m = 0; m < 4; ++m)
#pragma unroll
                    for (int n = 0; n < 2; ++n) acc[a][b][m][n] = (f32x4){0.f, 0.f, 0.f, 0.f};
        cur = nxt; cA = nA; cB = nB; ++ui;
        if constexpr (ALIGN_EPI) { if (wr == 1) PG8_BAR; }
    }
    PG8_WAIT_V(0);
    if constexpr (!ALIGN_EPI) { if (wr == 0) PG8_BAR; }
    PG8_BAR;
    if constexpr (Epi::AFTER_DRAIN) { E.fused(acc, cur, wr, wc, fr, fq, lds, wid, lane); S.done(cur); }
#undef PG8_SA
#undef PG8_KADV
#undef PG8_SB
#undef PG8_STAGE
#undef PG8_LDA
#undef PG8_LDB
#undef PG8_MMA
#undef PG8_WAIT_V
#undef PG8_WAIT_L
#undef PG8_BAR
#undef PG8_SCHED
}
}
constexpr int NWAVES = 8;
constexpr int BATCH = 4, SEQ = 4096, DM = 2048, FF = 5632, M = BATCH * SEQ, NH = 8, HD = 128, DF = 1024, DA = 1024, NMOD = 9, MODW = NMOD * DM;
constexpr float EPS = 1e-6f;
constexpr float QSCALE = 0.08838834764831845f * 1.4426950408889634f;

constexpr size_t MiB = 1u << 20;
constexpr size_t WS_CTL = 0, CTL_ZERO_BYTES = 1 * MiB;
constexpr size_t WS_MOD = 1 * MiB;
constexpr size_t WS_ROPE = 2 * MiB;
constexpr size_t WS_LSE = 6 * MiB;
constexpr size_t WS_YN = 7 * MiB + 768 * 1024;
constexpr size_t WS_NYQ = 7 * MiB + 512 * 1024;
constexpr size_t WS_PQ = 24 * MiB;
constexpr size_t WS_DMAT = 8 * MiB;
constexpr size_t WS_W = 72 * MiB;
constexpr size_t W_GU1 = 0, W_GU2 = 44 * MiB, W_D1 = 88 * MiB, W_D2 = 110 * MiB, W_F = 132 * MiB, W_QKV = 140 * MiB, W_OF = 152 * MiB, W_LAYER = 160 * MiB;
constexpr size_t WS_X = 392 * MiB;
constexpr size_t WS_H = 520 * MiB;
constexpr size_t WS_ACT = 584 * MiB;
constexpr size_t WS_UT = 760 * MiB;
constexpr size_t WS_HE = 792 * MiB;
constexpr size_t WS_HO = 1080 * MiB;
constexpr size_t WS_Q = 824 * MiB, WS_K = 856 * MiB, WS_V = 888 * MiB;
constexpr size_t WS_YF = 920 * MiB;
constexpr size_t WS_OP = 984 * MiB;
constexpr size_t WS_END = 1112 * MiB;
constexpr int CW_BAR = 4096;

constexpr int RING_BYTES = 131072;
constexpr int LDSCTL_OFF = RING_BYTES, MISC_OFF = LDSCTL_OFF + 320;
constexpr int LDS_BYTES = 147456;

#define GAS __attribute__((address_space(1)))
#define LAS __attribute__((address_space(3)))
typedef unsigned short bf16;
typedef unsigned v4u __attribute__((ext_vector_type(4)));
typedef unsigned v2u __attribute__((ext_vector_type(2)));
typedef float f32x4 __attribute__((ext_vector_type(4)));
typedef float f32x16 __attribute__((ext_vector_type(16)));
typedef short bf16x8 __attribute__((ext_vector_type(8)));
typedef short s16x4 __attribute__((ext_vector_type(4)));
typedef float f32x2_t __attribute__((ext_vector_type(2)));
typedef __bf16 bf16x2_t __attribute__((ext_vector_type(2)));
typedef GAS unsigned gu32;
#define LDS_WAIT() asm volatile("s_waitcnt lgkmcnt(0)" ::: "memory")
#define VM_WAIT() asm volatile("s_waitcnt vmcnt(0)" ::: "memory")
__device__ __forceinline__ unsigned pk2(float lo, float hi) { f32x2_t v = {lo, hi}; bf16x2_t b = __builtin_convertvector(v, bf16x2_t); return __builtin_bit_cast(unsigned, b); }
__device__ __forceinline__ v4u pk8(f32x4 a, f32x4 b) { v4u w; w.x = pk2(a[0], a[1]); w.y = pk2(a[2], a[3]); w.z = pk2(b[0], b[1]); w.w = pk2(b[2], b[3]); return w; }
typedef _Float16 h16x2_t __attribute__((ext_vector_type(2)));
__device__ __forceinline__ unsigned pkh2(float lo, float hi) { const h16x2_t h = {(_Float16)lo, (_Float16)hi}; return __builtin_bit_cast(unsigned, h); }
__device__ __forceinline__ v4u pkh8(f32x4 a, f32x4 b) { v4u w; w.x = pkh2(a[0], a[1]); w.y = pkh2(a[2], a[3]); w.z = pkh2(b[0], b[1]); w.w = pkh2(b[2], b[3]); return w; }
__device__ __forceinline__ f32x4 uph4(unsigned u0, unsigned u1) { const h16x2_t a = __builtin_bit_cast(h16x2_t, u0), b = __builtin_bit_cast(h16x2_t, u1); return (f32x4){(float)a[0], (float)a[1], (float)b[0], (float)b[1]}; }
__device__ __forceinline__ float bflo(unsigned u) { return __builtin_bit_cast(float, u << 16); }
__device__ __forceinline__ float bfhi(unsigned u) { return __builtin_bit_cast(float, u & 0xffff0000u); }
__device__ __forceinline__ float shfl_xor_f(float v, int o) {
    int l; asm volatile("v_mbcnt_lo_u32_b32 %0, -1, 0\n\tv_mbcnt_hi_u32_b32 %0, -1, %0" : "=v"(l));
    return __builtin_bit_cast(float, __builtin_amdgcn_ds_bpermute((l ^ o) << 2, __builtin_bit_cast(int, v)));
}
__device__ __forceinline__ float wave_sum(float v) {
#pragma unroll
    for (int o = 1; o < 64; o <<= 1) v += shfl_xor_f(v, o);
    return v;
}
#define XB_TMO      128
#define XB_XCNT(j)  (256  + 64 * (j))
#define XB_XSUB(j)  (1280 + 64 * (j))
#define XB_XGEN(j)  (2304 + 64 * (j))
#define XB_TOP      3328
#define XB_TOPGEN   3392
#define XCD_BAR_WORDS 3456
#define XB_SPIN_CAP (1u << 18)

__device__ __forceinline__ unsigned xb_ld(unsigned* p)              { return __hip_atomic_load(p, __ATOMIC_RELAXED, __HIP_MEMORY_SCOPE_AGENT); }
__device__ __forceinline__ unsigned xb_add(unsigned* p, unsigned v) { return __hip_atomic_fetch_add(p, v, __ATOMIC_RELAXED, __HIP_MEMORY_SCOPE_AGENT); }
__device__ __forceinline__ unsigned xb_xcc_id() { return (unsigned)__builtin_amdgcn_s_getreg((3 << 11) | 20) & 0xFu; }
#define XB_SPIN(cond, bar) do { unsigned _sp = 0; while (cond) { __builtin_amdgcn_s_sleep(1); \
    if ((++_sp & 255u) == 0u) { if (xb_ld(&(bar)[XB_TMO])) break; if (_sp > XB_SPIN_CAP) { atomicAdd(&(bar)[XB_TMO], 1u); break; } } } } while (0)

struct XcdBarrier {
    unsigned* bar; unsigned x;
    volatile LAS unsigned* st;
    int wv;
};
__device__ __forceinline__ int xb_lane() { int l; asm volatile("v_mbcnt_lo_u32_b32 %0, -1, 0\n\tv_mbcnt_hi_u32_b32 %0, -1, %0" : "=v"(l)); return l; }

__device__ __forceinline__ XcdBarrier xcd_barrier_post(unsigned* bar, volatile LAS unsigned* st) {
    XcdBarrier b; b.bar = bar; b.x = xb_xcc_id(); b.st = st; b.wv = 0;
    if (threadIdx.x == 0) (void)xb_add(&bar[XB_XCNT(b.x)], 1u);
    return b;
}
__device__ __forceinline__ void xcd_barrier_complete(unsigned* bar, unsigned x, unsigned& nloc, unsigned& nx) {
    const unsigned G = gridDim.x * gridDim.y * gridDim.z;
    unsigned sum, cnt, mine, sp = 0u;
    for (;;) {
        sum = 0u; cnt = 0u; mine = 0u;
#pragma unroll
        for (unsigned j = 0; j < 16; ++j) { const unsigned c = xb_ld(&bar[XB_XCNT(j)]); sum += c; cnt += (c > 0u) ? 1u : 0u; mine = (j == x) ? c : mine; }
        if (sum == G) break;
        __builtin_amdgcn_s_sleep(1);
        if ((++sp & 255u) == 0u) { if (xb_ld(&bar[XB_TMO])) break; if (sp > XB_SPIN_CAP) { atomicAdd(&bar[XB_TMO], 1u); break; } }
    }
    nloc = mine > 0u ? mine : 1u; nx = cnt > 0u ? cnt : 1u;
}

__device__ __forceinline__ void xcd_barrier(const XcdBarrier& b) {
    asm volatile("s_waitcnt vmcnt(0)" ::: "memory");
    __syncthreads();
    if (b.wv == 0 && xb_lane() == 0) {
        unsigned* bar = b.bar;
        __builtin_amdgcn_s_waitcnt(0);
        unsigned nloc = b.st[0], nx = b.st[1];
        if (nloc == 0u) { xcd_barrier_complete(bar, b.x, nloc, nx); b.st[0] = nloc; b.st[1] = nx; }
        const unsigned old = xb_add(&bar[XB_XSUB(b.x)], 1u);
        const unsigned gen = old / nloc;
        if (old + 1u == (gen + 1u) * nloc) {
            __builtin_amdgcn_fence(__ATOMIC_RELEASE, "agent");
            asm volatile("s_waitcnt vmcnt(0)" ::: "memory");
            const unsigned og = xb_add(&bar[XB_TOP], 1u);
            const unsigned tg = og / nx;
            if (og + 1u == (tg + 1u) * nx) xb_add(&bar[XB_TOPGEN], 1u);
            else XB_SPIN(xb_ld(&bar[XB_TOPGEN]) == tg, bar);
            __builtin_amdgcn_fence(__ATOMIC_ACQUIRE, "agent");
            xb_add(&bar[XB_XGEN(b.x)], 1u);
            asm volatile("s_waitcnt vmcnt(0)" ::: "memory");
        } else {
            XB_SPIN(xb_ld(&bar[XB_XGEN(b.x)]) == gen, bar);
            __builtin_amdgcn_fence(__ATOMIC_ACQUIRE, "agent");
            asm volatile("s_waitcnt vmcnt(0)" ::: "memory");
        }
    }
    __syncthreads();
}

typedef pg8::f32x4 accv;
struct EpiSwiGLU {
    static constexpr bool PERM = true, AFTER_DRAIN = false, MIDK = false;
    bf16* O;
    __device__ __forceinline__ void operator()(const accv (&acc)[2][2][4][2], const pg8::Unit& u, int wr, int wc, int fr, int fq) const {
        const int row0 = u.pm * 256 + wr * 64 + fr, col0 = u.pn * 128 + wc * 32 + 8 * fq;
#pragma unroll
        for (int ai = 0; ai < 2; ++ai)
#pragma unroll
            for (int m = 0; m < 4; ++m) {
                f32x4 a[2];
#pragma unroll
                for (int n = 0; n < 2; ++n)
#pragma unroll
                    for (int i = 0; i < 4; ++i) { const float g = acc[ai][0][m][n][i], up = acc[ai][1][m][n][i];
                        a[n][i] = g * __builtin_amdgcn_rcpf(1.f + __builtin_amdgcn_exp2f(-1.4426950408889634f * g)) * up; }
                *(v4u*)(O + (unsigned)((row0 + ai * 128 + m * 16) * FF + col0)) = pk8(a[0], a[1]);
            }
    }
};
template <int NP, int HALFSTEP, int XF32> struct EpiResid {
    static constexpr bool PERM = true, AFTER_DRAIN = false, MIDK = false;
    const void* xin; bf16* xout; const float* gate; const float* ssq;
    __device__ __forceinline__ void operator()(const accv (&acc)[2][2][4][2], const pg8::Unit& u, int wr, int wc, int fr, int fq) const {
        const int b = u.pm >> 4, row0 = u.pm * 256 + wr * 64 + fr, col0 = u.pn * 256 + wc * 32 + 8 * fq;
        f32x4 gv[2][2];
        if constexpr (XF32 == 0) {
#pragma unroll
            for (int bj = 0; bj < 2; ++bj)
#pragma unroll
                for (int n = 0; n < 2; ++n) asm volatile("global_load_dwordx4 %0, %1, off" : "=v"(gv[bj][n]) : "v"(gate + (unsigned)(b * MODW + col0 + bj * 128 + 4 * n)) : "memory");
        } else {
#pragma unroll
        for (int bj = 0; bj < 2; ++bj)
#pragma unroll
            for (int n = 0; n < 2; ++n) gv[bj][n] = *(const f32x4*)(gate + (unsigned)(b * MODW + col0 + bj * 128 + 4 * n)) * (HALFSTEP ? 0.5f : 1.f);
        }
        if constexpr (XF32 == 0) {
            v4u xr[4][2][2];
#define ER_LOAD(c_) do { _Pragma("unroll") for (int mm = 0; mm < 2; ++mm) _Pragma("unroll") for (int bj = 0; bj < 2; ++bj) \
                asm volatile("global_load_dwordx4 %0, %1, off" : "=v"(xr[c_][mm][bj]) : "v"((const bf16*)xin + (unsigned)((row0 + ((c_) >> 1) * 128 + (2 * ((c_) & 1) + mm) * 16) * DM + col0 + bj * 128)) : "memory"); } while (0)
#define ER_PIN(c_) asm volatile("" : "+v"(xr[c_][0][0]), "+v"(xr[c_][0][1]), "+v"(xr[c_][1][0]), "+v"(xr[c_][1][1]))
#define ER_PROC(c_) do { _Pragma("unroll") for (int mm = 0; mm < 2; ++mm) { const int ai = (c_) >> 1, m = 2 * ((c_) & 1) + mm, row = row0 + ai * 128 + m * 16; \
                _Pragma("unroll") for (int bj = 0; bj < 2; ++bj) { const unsigned off = (unsigned)(row * DM + col0 + bj * 128); const v4u xv = xr[c_][mm][bj]; \
                    const f32x4 x0 = (f32x4){bflo(xv[0]), bfhi(xv[0]), bflo(xv[1]), bfhi(xv[1])}, x1 = (f32x4){bflo(xv[2]), bfhi(xv[2]), bflo(xv[3]), bfhi(xv[3])}; \
                    *(v4u*)(xout + off) = pk8(x0 + gv[bj][0] * acc[ai][bj][m][0], x1 + gv[bj][1] * acc[ai][bj][m][1]); } } } while (0)
            ER_LOAD(0); ER_LOAD(1);
            asm volatile("s_waitcnt vmcnt(0)" ::: "memory");
            ER_PIN(0); ER_PIN(1);
            asm volatile("" : "+v"(gv[0][0]), "+v"(gv[0][1]), "+v"(gv[1][0]), "+v"(gv[1][1]));
            if (HALFSTEP) {
#pragma unroll
                for (int bj = 0; bj < 2; ++bj)
#pragma unroll
                    for (int n = 0; n < 2; ++n) gv[bj][n] = gv[bj][n] * 0.5f; }
            ER_PROC(0); ER_LOAD(2);
            ER_PROC(1); ER_LOAD(3);
            asm volatile("s_waitcnt vmcnt(8)" ::: "memory"); ER_PIN(2);
            ER_PROC(2);
            asm volatile("s_waitcnt vmcnt(4)" ::: "memory"); ER_PIN(3);
            ER_PROC(3);
            asm volatile("" ::: "memory");
#undef ER_LOAD
#undef ER_PIN
#undef ER_PROC
        } else {
#pragma unroll
        for (int ai = 0; ai < 2; ++ai) {
            v4u xr[4][2][2];
#pragma unroll
            for (int m = 0; m < 4; ++m)
#pragma unroll
                for (int bj = 0; bj < 2; ++bj) { const int row = row0 + ai * 128 + m * 16; const unsigned offi = (unsigned)(row * DM + col0 + bj * 128);
                    xr[m][bj][0] = *(const v4u*)((const float*)xin + offi); xr[m][bj][1] = *(const v4u*)((const float*)xin + offi + 4); }
            asm volatile("s_waitcnt vmcnt(0)" ::: "memory");
#pragma unroll
            for (int m = 0; m < 4; ++m) {
                const int row = row0 + ai * 128 + m * 16;
#pragma unroll
                for (int bj = 0; bj < 2; ++bj) { const unsigned off = (unsigned)(row * DM + col0 + bj * 128);
                    const f32x4 x0 = __builtin_bit_cast(f32x4, xr[m][bj][0]), x1 = __builtin_bit_cast(f32x4, xr[m][bj][1]);
                    *(v4u*)(xout + off) = pk8(x0 + gv[bj][0] * acc[ai][bj][m][0], x1 + gv[bj][1] * acc[ai][bj][m][1]); }
            }
            asm volatile("" ::: "memory");
        }
        }
    }
};
struct EpiUT {
    static constexpr bool PERM = true, AFTER_DRAIN = false, MIDK = false;
    bf16* UT;
    __device__ __forceinline__ void operator()(const accv (&acc)[2][2][4][2], const pg8::Unit& u, int wr, int wc, int fr, int fq) const {
        const int r0 = u.pm * 256 + wr * 64 + fr, c0 = u.pn * 256 + wc * 32 + 8 * fq;
#pragma unroll
        for (int ai = 0; ai < 2; ++ai)
#pragma unroll
            for (int m = 0; m < 4; ++m) { const int ch = r0 + ai * 128 + m * 16;
#pragma unroll
                for (int bj = 0; bj < 2; ++bj) { const int tok = c0 + bj * 128, b = tok >> 11, par = (tok >> 10) & 1, jp = tok & 1023;
                    *(v4u*)(UT + (unsigned)(par * (4096 * 1024) + (b * 1024 + ch) * 1024 + jp)) = pk8(acc[ai][bj][m][0], acc[ai][bj][m][1]); } }
    }
};
struct EpiQKV {
    static constexpr bool PERM = true, AFTER_DRAIN = false, MIDK = false;
    bf16 *Q, *K, *V; const float *rc, *rs;
    __device__ __forceinline__ void operator()(const accv (&acc)[2][2][4][2], const pg8::Unit& u, int wr, int wc, int fr, int fq) const {
        const int sect = u.pn >> 2, t = u.pn & 3, row0 = u.pm * 256 + wr * 64 + fr, j0 = wc * 32 + 8 * fq;
        if (sect == 2) {
#pragma unroll
            for (int ai = 0; ai < 2; ++ai)
#pragma unroll
                for (int m = 0; m < 4; ++m) { const int row = row0 + ai * 128 + m * 16;
#pragma unroll
                    for (int bj = 0; bj < 2; ++bj) *(v4u*)(V + (unsigned)(row * 1024 + t * 256 + bj * 128 + j0)) = pk8(acc[ai][bj][m][0], acc[ai][bj][m][1]); }
        } else {
            const int head = 2 * t + (j0 >> 6), d0 = j0 & 63; bf16* dst = sect ? K : Q; const float sc = sect ? 1.f : QSCALE;
#pragma unroll
            for (int ai = 0; ai < 2; ++ai)
#pragma unroll
                for (int m = 0; m < 4; ++m) { const int row = row0 + ai * 128 + m * 16, pos = row & 4095;
                    f32x4 o1[2], o2[2];
#pragma unroll
                    for (int n = 0; n < 2; ++n) { const f32x4 cv = *(const f32x4*)(rc + (unsigned)(pos * 64 + d0 + 4 * n)), sv = *(const f32x4*)(rs + (unsigned)(pos * 64 + d0 + 4 * n));
                        const f32x4 x1 = acc[ai][0][m][n], x2 = acc[ai][1][m][n];
                        o1[n] = (x1 * cv - x2 * sv) * sc; o2[n] = (x2 * cv + x1 * sv) * sc; }
                    bf16* p = dst + (unsigned)(row * 1024 + head * 128 + d0);
                    *(v4u*)p = pk8(o1[0], o1[1]); *(v4u*)(p + 64) = pk8(o2[0], o2[1]);
                    asm volatile("" ::: "memory"); }
        }
    }
};
struct EpiPQ {
    static constexpr bool PERM = true, AFTER_DRAIN = false, MIDK = false;
    unsigned short* O;
    __device__ __forceinline__ void operator()(const accv (&acc)[2][2][4][2], const pg8::Unit& u, int wr, int wc, int fr, int fq) const {
        const int row0 = u.pm * 256 + wr * 64 + fr, col0 = u.pn * 256 + wc * 32 + 8 * fq;
#pragma unroll
        for (int ai = 0; ai < 2; ++ai)
#pragma unroll
            for (int m = 0; m < 4; ++m)
#pragma unroll
                for (int bj = 0; bj < 2; ++bj) *(v4u*)(O + (unsigned)((row0 + ai * 128 + m * 16) * 4096 + col0 + bj * 128)) = pkh8(acc[ai][bj][m][0], acc[ai][bj][m][1]);
    }
};

template <int XF32> __device__ __forceinline__ void ld_row8(const void* rowp, int lane, int j, f32x4& a, f32x4& b) {
    if (XF32) { const f32x4* p = (const f32x4*)rowp + 2 * (lane + 64 * j); a = p[0]; b = p[1]; }
    else { const v4u xv = ((const v4u*)rowp)[lane + 64 * j]; a = (f32x4){bflo(xv[0]), bfhi(xv[0]), bflo(xv[1]), bfhi(xv[1])}; b = (f32x4){bflo(xv[2]), bfhi(xv[2]), bflo(xv[3]), bfhi(xv[3])}; }
}
__device__ __forceinline__ float ssq8(const f32x4& a, const f32x4& b) { return ((a[0] * a[0] + a[1] * a[1]) + (a[2] * a[2] + a[3] * a[3])) + ((b[0] * b[0] + b[1] * b[1]) + (b[2] * b[2] + b[3] * b[3])); }
__device__ __forceinline__ void p0_mod(LAS unsigned char* lds, const float* c, const float* w_ada, const float* b_ada, float* mod, int tid, int wave, int lane, int G) {
    LAS float* sl = (LAS float*)lds;
    LAS float* red = (LAS float*)(lds + 32768);
    for (int i = tid; i < 4 * DM; i += NWAVES * 64) { const float v = c[i]; sl[i] = v / (1.f + expf(-v)); }
    __syncthreads();
    for (int w = blockIdx.x; w < 256; w += G) {
        const int cg0 = 144 * w, l = cg0 / MODW, n0 = cg0 % MODW;
        if (lane < 36) {
            const float* Wp = w_ada + (size_t)l * DM * MODW + (size_t)(wave * 256) * MODW + n0 + 4 * lane;
            f32x4 a0 = {0.f, 0.f, 0.f, 0.f}, a1 = a0, a2 = a0, a3 = a0;
#pragma unroll 8
            for (int k = 0; k < 256; ++k) { const f32x4 wv = *(const f32x4*)(Wp + (size_t)k * MODW); const int kk = wave * 256 + k;
                a0 += wv * sl[kk]; a1 += wv * sl[DM + kk]; a2 += wv * sl[2 * DM + kk]; a3 += wv * sl[3 * DM + kk]; }
            LAS float* r = red + (wave * 36 + lane) * 16;
            *(LAS f32x4*)(r) = a0; *(LAS f32x4*)(r + 4) = a1; *(LAS f32x4*)(r + 8) = a2; *(LAS f32x4*)(r + 12) = a3;
        }
        __syncthreads();
        if (tid < 144) { const int ls = tid >> 2, cp = tid & 3;
#pragma unroll
            for (int b = 0; b < 4; ++b) { float s = b_ada[(size_t)l * MODW + n0 + tid];
#pragma unroll
                for (int v = 0; v < 8; ++v) s += red[(v * 36 + ls) * 16 + b * 4 + cp];
                mod[((size_t)l * 4 + b) * MODW + n0 + tid] = s; } }
        __syncthreads();
    }
}
__device__ __forceinline__ void p0_fold(LAS unsigned char* lds, const float* w_mix_in, const float* w_fourier, unsigned char* wsW, int tid, int G) {
    LAS float* tab = (LAS float*)lds;
    LAS float* Mx = (LAS float*)(lds + 512);
    LAS float* Wb = (LAS float*)(lds + 512 + 65536);
    const int lane = tid & 63, wv = tid >> 6, r32 = lane & 31, hi = lane >> 5;
    if (tid < 128) tab[tid] = cospif((float)tid * (1.f / 64.f)) * 0.08838834764831845f;
    __syncthreads();
    for (int w = blockIdx.x; w < 256; w += G) {
        const int combo = w >> 3, l = combo >> 4, g = (combo >> 1) & 7, part = combo & 1;
        const float* Wf = w_fourier + ((size_t)(l * 8 + g) * 128) * 128;
        { f32x16 acc[2];
#pragma unroll
          for (int tt = 0; tt < 2; ++tt)
#pragma unroll
              for (int i = 0; i < 16; ++i) acc[tt][i] = 0.f;
          for (int half = 0; half < 2; ++half) {
#pragma unroll
              for (int q = 0; q < 4; ++q) { const int i = tid + 512 * q, kk = i >> 5, c4 = i & 31;
                  *(LAS f32x4*)(Wb + kk * 128 + 4 * c4) = *(const f32x4*)(Wf + (size_t)(64 * half + kk) * 128 + 4 * c4); }
              __syncthreads();
#pragma unroll
              for (int tt = 0; tt < 2; ++tt) { const int tile = wv * 2 + tt, tc = tile >> 2, te = tile & 3, c = tc * 32 + r32, e = te * 32 + r32;
#pragma unroll 8
                  for (int kk = 0; kk < 32; ++kk) { const int kl = 2 * kk + hi, k2 = 64 * half + kl;
                      acc[tt] = __builtin_amdgcn_mfma_f32_32x32x2f32(tab[(k2 * c - (part ? 32 : 0)) & 127], Wb[kl * 128 + e], acc[tt], 0, 0, 0); } }
              __syncthreads();
          }
#pragma unroll
          for (int tt = 0; tt < 2; ++tt) { const int tile = wv * 2 + tt, tc = tile >> 2, te = tile & 3, e = te * 32 + r32;
#pragma unroll
              for (int i = 0; i < 16; ++i) Mx[(tc * 32 + (i & 3) + 8 * (i >> 2) + 4 * hi) * 128 + e] = acc[tt][i]; } }
        bf16* WfT = (bf16*)(wsW + (size_t)l * W_LAYER + W_F);
        f32x4 pre[4];
#pragma unroll
        for (int q = 0; q < 4; ++q) { const int i = tid + 512 * q, kk = i >> 5, c4 = i & 31; pre[q] = *(const f32x4*)(w_mix_in + ((size_t)l * DM + (w & 7) * 256 + kk) * 4096 + g * 128 + 4 * c4); }
        __syncthreads();
        for (int kb4 = 0; kb4 < 4; ++kb4) {
            const int k0 = ((w & 7) * 4 + kb4) * 64;
#pragma unroll
            for (int q = 0; q < 4; ++q) { const int i = tid + 512 * q, kk = i >> 5, c4 = i & 31; LAS float* d = Wb + kk * 129 + 4 * c4; d[0] = pre[q][0]; d[1] = pre[q][1]; d[2] = pre[q][2]; d[3] = pre[q][3]; }
            if (kb4 < 3) {
#pragma unroll
                for (int q = 0; q < 4; ++q) { const int i = tid + 512 * q, kk = i >> 5, c4 = i & 31; pre[q] = *(const f32x4*)(w_mix_in + ((size_t)l * DM + k0 + 64 + kk) * 4096 + g * 128 + 4 * c4); } }
            __syncthreads();
            { const int tr = wv >> 2, te = wv & 3, e = te * 32 + r32;
              f32x16 acc;
#pragma unroll
              for (int i = 0; i < 16; ++i) acc[i] = 0.f;
#pragma unroll 8
              for (int kk = 0; kk < 64; ++kk) { const int cc = 2 * kk + hi;
                  acc = __builtin_amdgcn_mfma_f32_32x32x2f32(Wb[(tr * 32 + r32) * 129 + cc], Mx[cc * 128 + e], acc, 0, 0, 0); }
              bf16* dst = WfT + (size_t)(part * 1024 + g * 128 + e) * DM + k0 + tr * 32 + 4 * hi;
#pragma unroll
              for (int g4 = 0; g4 < 4; ++g4) { v2u o; o.x = pk2(acc[4 * g4], acc[4 * g4 + 1]); o.y = pk2(acc[4 * g4 + 2], acc[4 * g4 + 3]); *(v2u*)(dst + 8 * g4) = o; } }
            __syncthreads();
        }
    }
}
__device__ __forceinline__ void p0_dmat(LAS unsigned char* lds, bf16* Dm, int tid, int G) {
    LAS float* ct = (LAS float*)lds;
    for (int i = tid; i < 4096; i += NWAVES * 64) ct[i] = cospif((float)i * (1.f / 2048.f)) * (1.f / 64.f);
    __syncthreads();
    for (int w = blockIdx.x; w < 256; w += G)
        for (int it = 0; it < 4; ++it) { const int id = w * 2048 + it * 512 + tid, mat = id >> 17, rem = id & 131071, row = rem >> 7, j0 = (rem & 127) * 8;
            float v[8];
#pragma unroll
            for (int j = 0; j < 8; ++j) v[j] = ct[(row * (2 * (j0 + j) + (mat & 1)) - ((mat >> 1) ? 1024 : 0)) & 4095];
            v4u o; o.x = pk2(v[0], v[1]); o.y = pk2(v[2], v[3]); o.z = pk2(v[4], v[5]); o.w = pk2(v[6], v[7]);
            *(v4u*)(Dm + (size_t)mat * 1024 * 1024 + (size_t)row * 1024 + j0) = o; }
    __syncthreads();
}
__device__ __forceinline__ void tr_item(const float* W, int ldw, int k0, int n0src, bf16* WT, int ldt, int drow0, int dk0, const float* gain, LAS float* scr, int lane) {
    { f32x4 v[8];
#pragma unroll
      for (int i = 0; i < 8; ++i) v[i] = *(const f32x4*)(W + (size_t)(k0 + 8 * i + (lane >> 3)) * ldw + n0src + 4 * (lane & 7));
#pragma unroll
      for (int i = 0; i < 8; ++i) { const int kk = 8 * i + (lane >> 3); f32x4 t = v[i]; if (gain) t = t * gain[k0 + kk];
          LAS float* d = scr + kk * 33 + 4 * (lane & 7); d[0] = t[0]; d[1] = t[1]; d[2] = t[2]; d[3] = t[3]; } }
    LDS_WAIT(); asm volatile("" ::: "memory");
    const int c = lane & 7;
#pragma unroll
    for (int j = 0; j < 4; ++j) { const int n = (lane >> 3) + 8 * j; const LAS float* s = scr + (8 * c) * 33 + n;
        v4u o; o.x = pk2(s[0 * 33], s[1 * 33]); o.y = pk2(s[2 * 33], s[3 * 33]); o.z = pk2(s[4 * 33], s[5 * 33]); o.w = pk2(s[6 * 33], s[7 * 33]);
        *(v4u*)(WT + (size_t)(drow0 + n) * ldt + dk0 + 8 * c) = o; }
    LDS_WAIT(); asm volatile("" ::: "memory");
}
constexpr int IT_GU = (DM / 64) * (2 * FF / 32), IT_D = (FF / 64) * (DM / 32), IT_QKV = (DM / 64) * (3072 / 32), IT_O = (DM / 64) * (DM / 32), IT_LAYER = 2 * IT_GU + 2 * IT_D + IT_QKV + IT_O;
__device__ __forceinline__ void p0_weights(LAS unsigned char* lds, const float* const* in, unsigned char* wsW, int gw, int NGW, int wave, int lane) {
    LAS float* scr = (LAS float*)(lds + wave * 16384);
    for (int it = gw; it < 2 * IT_LAYER; it += NGW) {
        const int l = it / IT_LAYER; int r = it % IT_LAYER; unsigned char* wl = wsW + (size_t)l * W_LAYER;
        if (r < 2 * IT_GU) { const int f = r / IT_GU; r %= IT_GU; const int nblk = 2 * FF / 32, kb = r / nblk, nb = r % nblk, n0 = 32 * nb;
            const int j0 = n0 < FF ? n0 : n0 - FF, drow = (j0 >> 7) * 256 + (n0 < FF ? 0 : 128) + (j0 & 127);
            tr_item(in[f ? 11 : 4] + (size_t)l * DM * 2 * FF, 2 * FF, 64 * kb, n0, (bf16*)(wl + (f ? W_GU2 : W_GU1)), DM, drow, 64 * kb, nullptr, scr, lane); continue; }
        r -= 2 * IT_GU;
        if (r < 2 * IT_D) { const int f = r / IT_D; r %= IT_D; const int nblk = DM / 32, kb = r / nblk, nb = r % nblk;
            tr_item(in[f ? 12 : 5] + (size_t)l * FF * DM, DM, 64 * kb, 32 * nb, (bf16*)(wl + (f ? W_D2 : W_D1)), FF, 32 * nb, 64 * kb, nullptr, scr, lane); continue; }
        r -= 2 * IT_D;
        if (r < IT_QKV) { const int nblk = 3072 / 32, kb = r / nblk, nb = r % nblk, n = 32 * nb, sect = n >> 10, within = n & 1023, hh = within >> 7, d = within & 127;
            const int drow = sect == 2 ? 2048 + within : sect * 1024 + 256 * (hh >> 1) + (d >> 6) * 128 + (hh & 1) * 64 + (d & 63);
            tr_item(in[6] + (size_t)l * DM * 4096, 4096, 64 * kb, 1024 + n, (bf16*)(wl + W_QKV), DM, drow, 64 * kb, nullptr, scr, lane); continue; }
        r -= IT_QKV;
        { const int nblk = DM / 32, kb = r / nblk, nb = r % nblk, k0 = 64 * kb; const bool fh = k0 < 1024;
          tr_item(in[10] + (size_t)l * DM * DM, DM, k0, 32 * nb, (bf16*)(wl + W_OF), DM, 32 * nb, k0,
                  fh ? in[8] + (size_t)l * DF : in[9] + (size_t)l * DA - 1024, scr, lane); }
    }
}
__device__ __forceinline__ void p0_rope(float* rc, float* rs, int gt, int NT) {
    for (int i = gt; i < 4096 * 64; i += NT) { const int pos = i >> 6, fi = i & 63;
        const float invf = exp2f(-(float)fi * 0.20762050593046014f);
        const float ang = (float)pos * invf;
        const double rev = (double)ang * 0.15915494309189535; const float fr = (float)(rev - floor(rev));
        rc[i] = __builtin_amdgcn_cosf(fr); rs[i] = __builtin_amdgcn_sinf(fr); }
}
template <int XF32> __device__ __forceinline__ void norm_mod_phase(const void* x, const float* modl, int ch_shift, int ch_scale, bf16* H, int gw, int NGW, int lane) {
    const size_t rowb = XF32 ? (size_t)DM * 4 : (size_t)DM * 2;
    for (int blk = gw; blk < M / 8; blk += NGW) {
        const int r0 = blk * 8, b = r0 >> 12;
        const f32x4* shp = (const f32x4*)(modl + (size_t)b * MODW + ch_shift * DM); const f32x4* scp = (const f32x4*)(modl + (size_t)b * MODW + ch_scale * DM);
        f32x4 sh[4][2], sc[4][2];
#pragma unroll
        for (int j = 0; j < 4; ++j)
#pragma unroll
            for (int q = 0; q < 2; ++q) { sh[j][q] = shp[2 * (lane + 64 * j) + q]; sc[j][q] = scp[2 * (lane + 64 * j) + q] + 1.f; }
        for (int rr = 0; rr < 8; ++rr) {
            const unsigned char* xr = (const unsigned char*)x + (size_t)(r0 + rr) * rowb; f32x4 v[4][2]; float s = 0.f;
#pragma unroll
            for (int j = 0; j < 4; ++j) ld_row8<XF32>(xr, lane, j, v[j][0], v[j][1]);
#pragma unroll
            for (int j = 0; j < 4; ++j) s += ssq8(v[j][0], v[j][1]);
            const float rstd = 1.f / sqrtf(wave_sum(s) * (1.f / DM) + EPS);
            v4u* o = (v4u*)(H + (size_t)(r0 + rr) * DM);
#pragma unroll
            for (int j = 0; j < 4; ++j) o[lane + 64 * j] = pk8(v[j][0] * rstd * sc[j][0] + sh[j][0], v[j][1] * rstd * sc[j][1] + sh[j][1]);
        }
    }
}
__device__ __forceinline__ void norm_mod_fold_phase(const bf16* x, const float* modl, int ch_shift, int ch_scale, bf16* H, bf16* HE, bf16* HO, int gw, int NGW, int lane) {
    for (int blk = gw; blk < BATCH * 512; blk += NGW) {
        const int b = blk >> 9, t0 = (blk & 511) * 4;
        const f32x4* shp = (const f32x4*)(modl + (size_t)b * MODW + ch_shift * DM); const f32x4* scp = (const f32x4*)(modl + (size_t)b * MODW + ch_scale * DM);
        f32x4 sh[4][2], sc[4][2];
#pragma unroll
        for (int j = 0; j < 4; ++j)
#pragma unroll
            for (int q = 0; q < 2; ++q) { sh[j][q] = shp[2 * (lane + 64 * j) + q]; sc[j][q] = scp[2 * (lane + 64 * j) + q] + 1.f; }
        for (int tt = 0; tt < 4; ++tt) {
            const int t = t0 + tt, ra = t, rb = t ? SEQ - t : SEQ / 2;
            const bf16* xa = x + (size_t)(b * SEQ + ra) * DM; const bf16* xb = x + (size_t)(b * SEQ + rb) * DM;
            f32x4 va[4][2], vb[4][2]; float sa = 0.f, sb = 0.f;
#pragma unroll
            for (int j = 0; j < 4; ++j) { ld_row8<0>(xa, lane, j, va[j][0], va[j][1]); ld_row8<0>(xb, lane, j, vb[j][0], vb[j][1]); }
#pragma unroll
            for (int j = 0; j < 4; ++j) { sa += ssq8(va[j][0], va[j][1]); sb += ssq8(vb[j][0], vb[j][1]); }
            const float ra_ = 1.f / sqrtf(wave_sum(sa) * (1.f / DM) + EPS), rb_ = 1.f / sqrtf(wave_sum(sb) * (1.f / DM) + EPS);
            v4u* oa = (v4u*)(H + (size_t)(b * SEQ + ra) * DM); v4u* ob = (v4u*)(H + (size_t)(b * SEQ + rb) * DM);
            const int fr_ = b * 2048 + (t & 1) * 1024 + (t >> 1);
            v4u* oe = (v4u*)(HE + (size_t)fr_ * DM); v4u* oo = (v4u*)(HO + (size_t)fr_ * DM);
            const f32x4 z4 = {0.f, 0.f, 0.f, 0.f};
#pragma unroll
            for (int j = 0; j < 4; ++j) { const f32x4 ya0 = va[j][0] * ra_ * sc[j][0] + sh[j][0], ya1 = va[j][1] * ra_ * sc[j][1] + sh[j][1], yb0 = vb[j][0] * rb_ * sc[j][0] + sh[j][0], yb1 = vb[j][1] * rb_ * sc[j][1] + sh[j][1];
                oa[lane + 64 * j] = pk8(ya0, ya1); ob[lane + 64 * j] = pk8(yb0, yb1);
                oe[lane + 64 * j] = t ? pk8(ya0 + yb0, ya1 + yb1) : pk8(ya0, ya1);
                oo[lane + 64 * j] = t ? pk8(ya0 - yb0, ya1 - yb1) : pk8(z4, z4); }
        }
    }
}
__device__ __forceinline__ void nyq_phase(const bf16* H, const bf16* WfT, float* nyq, int gw, int NGW, int lane) {
    for (int ch = gw; ch < 1024; ch += NGW) {
        const v4u* wp = (const v4u*)(WfT + (size_t)ch * DM) + lane; v4u wv[4];
#pragma unroll
        for (int j = 0; j < 4; ++j) wv[j] = wp[64 * j];
#pragma unroll
        for (int b = 0; b < 4; ++b) { const v4u* hp = (const v4u*)(H + (size_t)(b * SEQ + SEQ / 2) * DM) + lane; float s = 0.f;
#pragma unroll
            for (int j = 0; j < 4; ++j) { const v4u hv = hp[64 * j];
#pragma unroll
                for (int e = 0; e < 4; ++e) s += bflo(wv[j][e]) * bflo(hv[e]) + bfhi(wv[j][e]) * bfhi(hv[e]); }
            s = wave_sum(s); if (lane == 0) nyq[b * 1024 + ch] = s; }
    }
}
__device__ __forceinline__ void quarter_row_phase(const bf16* UTEe, const bf16* UTOo, float* yE, float* yO, int gw, int NGW, int lane) {
    for (int r = gw; r < 4096; r += NGW) { const v4u* pe = (const v4u*)(UTEe + (size_t)r * 1024) + lane; const v4u* po = (const v4u*)(UTOo + (size_t)r * 1024) + lane; float se = 0.f, so = 0.f;
#pragma unroll
        for (int q = 0; q < 2; ++q) { const v4u ve = pe[64 * q], vo = po[64 * q];
#pragma unroll
            for (int e = 0; e < 4; ++e) { se += bflo(ve[e]) - bfhi(ve[e]); so += bflo(vo[e]) - bfhi(vo[e]); } }
        se = wave_sum(se); so = wave_sum(so); if (lane == 0) { yE[r] = se * (1.f / 64.f); yO[r] = so * (1.f / 64.f); } }
}
__device__ __forceinline__ void ld16(const unsigned short* p, f32x4 (&v)[4]) { const v4u a = ((const v4u*)p)[0], b = ((const v4u*)p)[1]; v[0] = uph4(a.x, a.y); v[1] = uph4(a.z, a.w); v[2] = uph4(b.x, b.y); v[3] = uph4(b.z, b.w); }
__device__ __forceinline__ void st_row_norm(bf16* Y, int row, int lane, const f32x4 (&y)[4]) {
    float ss = 0.f;
#pragma unroll
    for (int q = 0; q < 4; ++q) ss += (y[q][0] * y[q][0] + y[q][1] * y[q][1]) + (y[q][2] * y[q][2] + y[q][3] * y[q][3]);
    const float rs = 1.f / sqrtf(wave_sum(ss) * (1.f / 1024.f) + EPS);
    v4u* o = (v4u*)(Y + (size_t)row * 2048 + 16 * lane); o[0] = pk8(y[0] * rs, y[1] * rs); o[1] = pk8(y[2] * rs, y[3] * rs);
}
__device__ __forceinline__ void combine_phase(const unsigned short* PQ4, const float* nyq, const float* yE, const float* yO, const bf16* OP, const float* LSE, bf16* Y, int gw, int NGW, int lane) {
    for (int t = gw; t < BATCH * 1025; t += NGW) {
        const int b = t / 1025, k = t - b * 1025;
        f32x4 ep[4], op[4], eq[4], oq[4], n[4];
        const float sg = (k & 1) ? -1.f / 64.f : 1.f / 64.f;
#pragma unroll
        for (int q = 0; q < 4; ++q) n[q] = *(const f32x4*)(nyq + b * 1024 + 16 * lane + 4 * q) * sg;
        if (k < 1024) { const size_t off = (size_t)k * 4096 + b * 1024 + 16 * lane;
            ld16(PQ4 + off, ep); ld16(PQ4 + (size_t)1024 * 4096 + off, op); ld16(PQ4 + (size_t)2 * 1024 * 4096 + off, eq); ld16(PQ4 + (size_t)3 * 1024 * 4096 + off, oq);
        } else {
#pragma unroll
            for (int q = 0; q < 4; ++q) { ep[q] = *(const f32x4*)(yE + b * 1024 + 16 * lane + 4 * q); oq[q] = *(const f32x4*)(yO + b * 1024 + 16 * lane + 4 * q); op[q] = (f32x4){0.f, 0.f, 0.f, 0.f}; eq[q] = op[q]; } }
        f32x4 y[4];
#pragma unroll
        for (int q = 0; q < 4; ++q) y[q] = (ep[q] + op[q]) - (eq[q] + oq[q]) + n[q];
        st_row_norm(Y, b * SEQ + k, lane, y);
        if (k > 0) {
#pragma unroll
            for (int q = 0; q < 4; ++q) y[q] = (ep[q] + op[q]) + (eq[q] + oq[q]) + n[q];
            st_row_norm(Y, b * SEQ + SEQ - k, lane, y); }
        if (k < 1024) {
#pragma unroll
            for (int q = 0; q < 4; ++q) y[q] = (ep[q] - op[q]) - (oq[q] - eq[q]) + n[q];
            st_row_norm(Y, b * SEQ + SEQ / 2 - k, lane, y); }
        if (k > 0 && k < 1024) {
#pragma unroll
            for (int q = 0; q < 4; ++q) y[q] = (ep[q] - op[q]) + (oq[q] - eq[q]) + n[q];
            st_row_norm(Y, b * SEQ + SEQ / 2 + k, lane, y); }
    }
    for (int tok = gw; tok < M; tok += NGW) {
        const int h = lane >> 3;
        float l0 = LSE[(size_t)tok * 8 + h], l1 = LSE[(size_t)M * 8 + (size_t)tok * 8 + h], l2 = LSE[(size_t)2 * M * 8 + (size_t)tok * 8 + h];
        const v4u* a = (const v4u*)(OP + (size_t)tok * 1024 + 16 * lane); const v4u* bq = (const v4u*)(OP + (size_t)M * 1024 + (size_t)tok * 1024 + 16 * lane); const v4u* cq = (const v4u*)(OP + (size_t)2 * M * 1024 + (size_t)tok * 1024 + 16 * lane);
        const v4u a0 = a[0], a1 = a[1], b0 = bq[0], b1 = bq[1], c0 = cq[0], c1 = cq[1];
        const float lm = fmaxf(l0, fmaxf(l1, l2)); l0 = __builtin_amdgcn_exp2f(l0 - lm); l1 = __builtin_amdgcn_exp2f(l1 - lm); l2 = __builtin_amdgcn_exp2f(l2 - lm);
        const float iw = 1.f / (l0 + l1 + l2); l0 *= iw; l1 *= iw; l2 *= iw;
        float y[16]; float ss = 0.f;
#pragma unroll
        for (int j = 0; j < 4; ++j) { y[2 * j] = l0 * bflo(a0[j]) + l1 * bflo(b0[j]) + l2 * bflo(c0[j]); y[2 * j + 1] = l0 * bfhi(a0[j]) + l1 * bfhi(b0[j]) + l2 * bfhi(c0[j]);
            y[8 + 2 * j] = l0 * bflo(a1[j]) + l1 * bflo(b1[j]) + l2 * bflo(c1[j]); y[8 + 2 * j + 1] = l0 * bfhi(a1[j]) + l1 * bfhi(b1[j]) + l2 * bfhi(c1[j]); }
#pragma unroll
        for (int j = 0; j < 16; ++j) ss += y[j] * y[j];
        const float rs = 1.f / sqrtf(wave_sum(ss) * (1.f / 1024.f) + EPS);
        v4u o0, o1; o0.x = pk2(y[0] * rs, y[1] * rs); o0.y = pk2(y[2] * rs, y[3] * rs); o0.z = pk2(y[4] * rs, y[5] * rs); o0.w = pk2(y[6] * rs, y[7] * rs);
        o1.x = pk2(y[8] * rs, y[9] * rs); o1.y = pk2(y[10] * rs, y[11] * rs); o1.z = pk2(y[12] * rs, y[13] * rs); o1.w = pk2(y[14] * rs, y[15] * rs);
        v4u* o = (v4u*)(Y + (size_t)tok * 2048 + 1024 + 16 * lane); o[0] = o0; o[1] = o1;
    }
}
__device__ __forceinline__ void final_norm_phase(const bf16* x, const float* gain, float* out, int gw, int NGW, int lane) {
    f32x4 gv[4][2];
#pragma unroll
    for (int j = 0; j < 4; ++j)
#pragma unroll
        for (int q = 0; q < 2; ++q) gv[j][q] = ((const f32x4*)gain)[2 * (lane + 64 * j) + q];
    for (int row = gw; row < M; row += NGW) {
        const bf16* xr = x + (size_t)row * DM; f32x4 v[4][2]; float s = 0.f;
#pragma unroll
        for (int j = 0; j < 4; ++j) ld_row8<0>(xr, lane, j, v[j][0], v[j][1]);
#pragma unroll
        for (int j = 0; j < 4; ++j) s += ssq8(v[j][0], v[j][1]);
        const float rstd = 1.f / sqrtf(wave_sum(s) * (1.f / DM) + EPS);
        f32x4* o = (f32x4*)(out + (size_t)row * DM);
#pragma unroll
        for (int j = 0; j < 4; ++j) { o[2 * (lane + 64 * j)] = v[j][0] * rstd * gv[j][0]; o[2 * (lane + 64 * j) + 1] = v[j][1] * rstd * gv[j][1]; }
    }
}

__device__ __forceinline__ int crow(int i, int hi) { return (i & 3) + 8 * (i >> 2) + 4 * hi; }
__device__ __forceinline__ unsigned voff(unsigned row, unsigned ch) { return 256u * row + 16u * (ch ^ (((row & 3u) << 2) | ((row >> 2) & 3u))); }
__device__ __forceinline__ s16x4 vtr(const LAS unsigned char* p) { return __builtin_bit_cast(s16x4, __builtin_amdgcn_ds_read_tr16_b64_v4i16((LAS s16x4*)p)); }
__device__ __forceinline__ void attn_chain(LAS unsigned char* lds, const bf16* Qb, const bf16* Kb, const bf16* Vb, bf16* Ob, float* lseb, int g0, int wave, int lane) {
    constexpr int NJOB = 6, NKB = 8 * NJOB + 4, NSTEP = 5 * NJOB + 4;
    const int r32 = lane & 31, hi = lane >> 5;
    const unsigned blk = (lane >> 4) & 1, tq = (lane & 15) >> 2, tp = lane & 3;
    const int prow = 4 * wave + (lane >> 4);
    const int ksrc = (lane & 15) ^ (prow & 15);
    const int vsrc = (lane & 15) ^ (((prow & 3) << 2) | ((prow >> 2) & 3));
    const int cw = (5 * wave) >> 3;
    const unsigned kbl = 256u * r32 + 16u * ((8u * hi) ^ (r32 & 15));
    unsigned trb[4][2];
#pragma unroll
    for (int d = 0; d < 4; ++d)
#pragma unroll
        for (int t2 = 0; t2 < 2; ++t2) trb[d][t2] = voff(8 * t2 + 4 * hi + tq, 4 * d + 2 * blk + (tp >> 1)) + 8 * (tp & 1);
#define AC_MAP(g_, p_, dil_, res_, loc_) const int p_ = (g_) >> 7, sh##p_ = 7 - 2 * p_, dil_ = 1 << (2 * p_), res_ = ((g_) & 127) >> sh##p_, loc_ = (g_) & ((1 << sh##p_) - 1)
#define AC_ISSUE(kk_) do { int u_ = g0 + (kk_) - 2; u_ = u_ < 0 ? 0 : (u_ > 383 ? 383 : u_); AC_MAP(u_, pu_, du_, ru_, lu_); \
    const size_t rowoff_ = (size_t)(ru_ + du_ * (32 * lu_ + prow)) * 1024; \
    LAS unsigned char* sl_ = lds + ((kk_) & 7) * 16384 + wave * 1024; \
    __builtin_amdgcn_global_load_lds((const unsigned*)(Kb + rowoff_ + 8 * ksrc), (LAS unsigned*)sl_, 16, 0, 0); \
    __builtin_amdgcn_global_load_lds((const unsigned*)(Vb + rowoff_ + 8 * vsrc), (LAS unsigned*)(sl_ + 8192), 16, 0, 0); } while (0)
#define AC_QLOAD(n_) do { const int gq_ = g0 + wave + 8 * (n_); AC_MAP(gq_, pq_, dq_, rq_, lq_); \
    const bf16* qp_ = Qb + (size_t)(rq_ + dq_ * (32 * lq_ + r32)) * 1024 + 64 * hi; \
    _Pragma("unroll") for (int s_ = 0; s_ < 8; ++s_) asm volatile("global_load_dwordx4 %0, %1, off" : "=v"(qn[s_]) : "v"(qp_ + 8 * s_) : "memory"); } while (0)
#define AC_FINALIZE(n_) do { const int gq_ = g0 + wave + 8 * (n_); AC_MAP(gq_, pq_, dq_, rq_, lq_); \
    const int qpos = rq_ + dq_ * (32 * lq_ + r32); \
    const float lt = l_run + shfl_xor_f(l_run, 32), inv = 1.f / lt; \
    bf16* op = Ob + (size_t)pq_ * M * 1024 + (size_t)qpos * 1024 + 8 * hi; \
    _Pragma("unroll") \
    for (int d = 0; d < 4; ++d) \
    _Pragma("unroll") \
    for (int j2 = 0; j2 < 2; ++j2) {   \
        unsigned a0 = pk2(o[d][8 * j2] * inv, o[d][8 * j2 + 1] * inv), a1 = pk2(o[d][8 * j2 + 2] * inv, o[d][8 * j2 + 3] * inv); \
        unsigned b0 = pk2(o[d][8 * j2 + 4] * inv, o[d][8 * j2 + 5] * inv), b1 = pk2(o[d][8 * j2 + 6] * inv, o[d][8 * j2 + 7] * inv); \
        const auto r0_ = __builtin_amdgcn_permlane32_swap(a0, b0, false, false); const auto r1_ = __builtin_amdgcn_permlane32_swap(a1, b1, false, false); \
        v4u w; w.x = r0_[0]; w.y = r1_[0]; w.z = r0_[1]; w.w = r1_[1]; \
        *(v4u*)(op + 32 * d + 16 * j2) = w; } \
    if (hi == 0) lseb[(size_t)pq_ * M * 8 + (size_t)qpos * 8] = m_run + log2f(lt); \
    m_run = -1e30f; l_run = 0.f; \
    _Pragma("unroll") for (int d = 0; d < 4; ++d) _Pragma("unroll") for (int i = 0; i < 16; ++i) o[d][i] = 0.f; } while (0)
    f32x16 o[4]; float m_run = -1e30f, l_run = 0.f; bf16x8 qf[8], qn[8];
    AC_QLOAD(0);
    AC_ISSUE(0); AC_ISSUE(1); AC_ISSUE(2); AC_ISSUE(3);
#pragma unroll
    for (int d = 0; d < 4; ++d)
#pragma unroll
        for (int i = 0; i < 16; ++i) o[d][i] = 0.f;
    int p1 = 4;
    int ph = 0, mm = 0;
    for (int s = 0; s < NSTEP; ++s) {
        const int rel = s - cw; const bool act = rel >= 0 && rel < 5 * NJOB;
        const int n = act ? rel / 5 : 0, t = act ? rel - 5 * n : 3;
        { const int y = p1 + ((act && n > 0 && (t == 1 || t == 2)) ? 9 : (act && t == 4 && n + 1 < NJOB) ? 8 : 0);
          if (y == 2) asm volatile("s_waitcnt vmcnt(2) lgkmcnt(0)" ::: "memory");
          else if (y == 4) asm volatile("s_waitcnt vmcnt(4) lgkmcnt(0)" ::: "memory");
          else if (y == 8) asm volatile("s_waitcnt vmcnt(8) lgkmcnt(0)" ::: "memory");
          else if (y == 10) asm volatile("s_waitcnt vmcnt(10) lgkmcnt(0)" ::: "memory");
          else if (y == 12) asm volatile("s_waitcnt vmcnt(12) lgkmcnt(0)" ::: "memory");
          else if (y == 9) asm volatile("s_waitcnt vmcnt(9) lgkmcnt(0)" ::: "memory");
          else if (y == 11) asm volatile("s_waitcnt vmcnt(11) lgkmcnt(0)" ::: "memory");
          else if (y == 13) asm volatile("s_waitcnt vmcnt(13) lgkmcnt(0)" ::: "memory");
          else asm volatile("s_waitcnt vmcnt(0) lgkmcnt(0)" ::: "memory"); }
        if (act && t == 0) {
            asm volatile("" : "+v"(qn[0]), "+v"(qn[1]), "+v"(qn[2]), "+v"(qn[3]), "+v"(qn[4]), "+v"(qn[5]), "+v"(qn[6]), "+v"(qn[7]));
#pragma unroll
            for (int s2 = 0; s2 < 8; ++s2) qf[s2] = qn[s2];
        }
        __builtin_amdgcn_s_barrier();
        asm volatile("" ::: "memory");
        { int k0, k1 = -1;
          if (ph == 0) k0 = 8 * mm + 4; else if (ph == 1) { k0 = 8 * mm + 5; k1 = k0 + 1; } else if (ph == 2) k0 = 8 * mm + 7; else if (ph == 3) { k0 = 8 * mm + 8; k1 = k0 + 1; } else { k0 = 8 * mm + 10; k1 = k0 + 1; }
          p1 = 0;
          if (k0 < NKB) { AC_ISSUE(k0); p1 = 2; }
          if (k1 >= 0 && k1 < NKB) { AC_ISSUE(k1); p1 += 2; } }
        if (++ph == 5) { ph = 0; ++mm; }
        if (act && t == 3 && n + 1 < NJOB) AC_QLOAD(n + 1);
        if (act) {
            if (t == 0 && n > 0) AC_FINALIZE(n - 1);
            const int L = wave + 8 * n, kk = L + t, gq = g0 + L, gk = gq - 2 + t;
            AC_MAP(gq, pq, dq, rq, lq);
            const bool valid = gk >= 0 && gk < 384 && (gk >> 7) == pq && (((gk & 127) >> shpq) == rq);
            (void)dq; (void)lq;
            if (valid) {
                const unsigned kb_ = kbl + (unsigned)(kk & 7) * 16384u;
                bf16x8 kf[8];
#pragma unroll
                for (int s2 = 0; s2 < 8; ++s2) kf[s2] = *(const LAS bf16x8*)(lds + (kb_ ^ ((unsigned)s2 << 4)));
                f32x16 sa;
#pragma unroll
                for (int i = 0; i < 16; ++i) sa[i] = 0.f;
                __builtin_amdgcn_sched_barrier(0); asm volatile("s_waitcnt lgkmcnt(0)" ::: "memory"); __builtin_amdgcn_sched_barrier(0);
#pragma unroll
                for (int s2 = 0; s2 < 8; ++s2) sa = __builtin_amdgcn_mfma_f32_32x32x16_bf16(kf[s2], qf[s2], sa, 0, 0, 0);
                if (t == 0 || t == 4) { const int dbase = 32 * t + 4 * hi - r32;
#pragma unroll
                  for (int i = 0; i < 16; ++i) if ((unsigned)(dbase + (i & 3) + 8 * (i >> 2)) > 128u) sa[i] = -1e30f; }
                float pmax = sa[0];
#pragma unroll
                for (int i = 1; i < 16; ++i) pmax = fmaxf(pmax, sa[i]);
                pmax = fmaxf(pmax, shfl_xor_f(pmax, 32));
                const float mn = fmaxf(m_run, pmax), alpha = __builtin_amdgcn_exp2f(m_run - mn); m_run = mn;
                float ps = 0.f;
#pragma unroll
                for (int i = 0; i < 16; ++i) { sa[i] = __builtin_amdgcn_exp2f(sa[i] - mn); ps += sa[i]; }
                l_run = l_run * alpha + ps;
#pragma unroll
                for (int d = 0; d < 4; ++d)
#pragma unroll
                    for (int i = 0; i < 16; ++i) o[d][i] *= alpha;
                bf16x8 pa[2];
#pragma unroll
                for (int s2 = 0; s2 < 2; ++s2) { v4u w; w.x = pk2(sa[8 * s2], sa[8 * s2 + 1]); w.y = pk2(sa[8 * s2 + 2], sa[8 * s2 + 3]); w.z = pk2(sa[8 * s2 + 4], sa[8 * s2 + 5]); w.w = pk2(sa[8 * s2 + 6], sa[8 * s2 + 7]);
                    pa[s2] = __builtin_bit_cast(bf16x8, w); }
                const unsigned so_ = (unsigned)(uintptr_t)lds + (unsigned)(kk & 7) * 16384u + 8192u;
                s16x4 lo[2][4], hh[2][4];
#pragma unroll
                for (int d = 0; d < 4; ++d) { const unsigned a0_ = trb[d][0] + so_, a1_ = trb[d][1] + so_;
                    asm volatile("ds_read_b64_tr_b16 %0, %1" : "=&v"(lo[0][d]) : "v"(a0_) : "memory");
                    asm volatile("ds_read_b64_tr_b16 %0, %1" : "=&v"(hh[0][d]) : "v"(a1_) : "memory");
                    asm volatile("ds_read_b64_tr_b16 %0, %1 offset:4096" : "=&v"(lo[1][d]) : "v"(a0_) : "memory");
                    asm volatile("ds_read_b64_tr_b16 %0, %1 offset:4096" : "=&v"(hh[1][d]) : "v"(a1_) : "memory"); }
                asm volatile("s_waitcnt lgkmcnt(0)" ::: "memory"); __builtin_amdgcn_sched_barrier(0);
#pragma unroll
                for (int s2 = 0; s2 < 2; ++s2)
#pragma unroll
                    for (int d = 0; d < 4; ++d) { const bf16x8 vt = {lo[s2][d][0], lo[s2][d][1], lo[s2][d][2], lo[s2][d][3], hh[s2][d][0], hh[s2][d][1], hh[s2][d][2], hh[s2][d][3]};
                        o[d] = __builtin_amdgcn_mfma_f32_32x32x16_bf16(vt, pa[s2], o[d], 0, 0, 0); }
            }
        }
    }
    AC_FINALIZE(NJOB - 1);
    asm volatile("s_waitcnt vmcnt(0) lgkmcnt(0)" ::: "memory");
    __builtin_amdgcn_s_barrier();
    asm volatile("" ::: "memory");
#undef AC_MAP
#undef AC_ISSUE
#undef AC_QLOAD
#undef AC_FINALIZE
}
__device__ __forceinline__ void attn_phase(LAS unsigned char* lds, const bf16* Q, const bf16* K, const bf16* V, bf16* OP, float* LSE, int wave, int lane, int bx, int G) {
    for (int item = bx; item < 256; item += G) {
        const int xg = item & 7, lw = item >> 3, bh = 4 * xg + (lw >> 3), b = bh >> 3, h = bh & 7, cseg = lw & 7;
        const size_t base = (size_t)b * SEQ * 1024 + h * 128;
        attn_chain(lds, Q + base, K + base, V + base, OP + base, LSE + (size_t)b * SEQ * 8 + h, 48 * cseg, wave, lane);
    }
}

struct Args { const float* in[14]; float* out; unsigned char* ws; };
__global__ void __launch_bounds__(NWAVES * 64, 2) hybrid_fwd(Args args) {
    extern __shared__ __attribute__((aligned(16))) unsigned char lds_raw[];
    LAS unsigned char* lds = (LAS unsigned char*)lds_raw;
    volatile LAS unsigned* MISC = (volatile LAS unsigned*)(lds + MISC_OFF);
    const int tid = threadIdx.x, lane = tid & 63, wave = __builtin_amdgcn_readfirstlane(tid >> 6);
    const int G = gridDim.x; const int bx = blockIdx.x; const int vcu = (G % 8 == 0) ? (bx % 8) * (G / 8) + bx / 8 : bx;
    const int gw = vcu * NWAVES + wave, NGW = G * NWAVES;
    unsigned char* ws = args.ws;
    gu32* ctl = (gu32*)(ws + WS_CTL);
    for (int u = tid; u < (LDS_BYTES - LDSCTL_OFF) / 4; u += NWAVES * 64) ((LAS unsigned*)(lds + LDSCTL_OFF))[u] = 0u;
    __syncthreads();
    XcdBarrier bar = xcd_barrier_post((unsigned*)(ctl + CW_BAR), MISC + 8); bar.wv = wave;
#define GRID_BAR() do { XcdBarrier b2_ = bar; b2_.x = xb_xcc_id(); { unsigned zb_ = 0u; asm volatile("" : "+s"(zb_)); b2_.bar = bar.bar + zb_; } xcd_barrier(b2_); } while (0)

    p0_mod(lds, args.in[1], args.in[2], args.in[3], (float*)(ws + WS_MOD), tid, wave, lane, G);
    p0_fold(lds, args.in[6], args.in[7], ws + WS_W, tid, G);
    p0_dmat(lds, (bf16*)(ws + WS_DMAT), tid, G);
    p0_weights(lds, args.in, ws + WS_W, gw, NGW, wave, lane);
    p0_rope((float*)(ws + WS_ROPE), (float*)(ws + WS_ROPE) + 4096 * 64, gw * 64 + lane, NGW * 64);
    GRID_BAR();

    for (int l = 0; l < 2; ++l) {
        unsigned zo_ = 0u; asm volatile("" : "+s"(zo_));
        unsigned char* wsl = args.ws + zo_;
        const int lane = xb_lane();
        int bxl = blockIdx.x, Gl = gridDim.x; asm volatile("" : "+s"(bxl), "+s"(Gl));
        const int bx = bxl, G = Gl, vcu = (G % 8 == 0) ? (bx % 8) * (G / 8) + bx / 8 : bx, gw = vcu * NWAVES + wave, NGW = G * NWAVES;
        float* mod = (float*)(wsl + WS_MOD);
        float* rc = (float*)(wsl + WS_ROPE); float* rsn = rc + 4096 * 64;
        float* LSE = (float*)(wsl + WS_LSE);
        bf16* Dm = (bf16*)(wsl + WS_DMAT); bf16* HE = (bf16*)(wsl + WS_HE); bf16* HO = (bf16*)(wsl + WS_HO); float* nyq = (float*)(wsl + WS_NYQ); float* yN = (float*)(wsl + WS_YN); unsigned short* PQ = (unsigned short*)(wsl + WS_ACT);
        bf16* X = (bf16*)(wsl + WS_X); bf16* H = (bf16*)(wsl + WS_H); bf16* ACT = (bf16*)(wsl + WS_ACT); bf16* UT = (bf16*)(wsl + WS_UT);
        bf16* Qb = (bf16*)(wsl + WS_Q); bf16* Kb = (bf16*)(wsl + WS_K); bf16* Vb = (bf16*)(wsl + WS_V); bf16* YF = (bf16*)(wsl + WS_YF); bf16* OP = (bf16*)(wsl + WS_OP);
        const float* modl = mod + (size_t)l * 4 * MODW;
        unsigned char* wl = wsl + WS_W + (size_t)l * W_LAYER;
        if (l == 0) norm_mod_phase<1>(args.in[0], modl, 0, 1, H, gw, NGW, xb_lane()); else norm_mod_phase<0>(X, modl, 0, 1, H, gw, NGW, xb_lane());
        GRID_BAR();
        { pg8::Gemm g{H, (const bf16*)(wl + W_GU1), M, 2 * FF, DM}; pg8::StaticOrderT<M, 2 * FF> S; S.init(G, bx);
          EpiSwiGLU E{ACT}; pg8::gemm_phase<EpiSwiGLU, pg8::StaticOrderT<M, 2 * FF>, true, true, DM>(lds, g, S, E, wave); }
        GRID_BAR();
        { pg8::Gemm g{ACT + (FF - 64), (const bf16*)(wl + W_D1) + (FF - 64), M, DM, FF}; pg8::StaticOrderT<M, DM, 4> S; S.init(G, bx);
          if (l == 0) { EpiResid<0, 1, 1> E{args.in[0], X, modl + 2 * DM, nullptr}; pg8::gemm_phase<EpiResid<0, 1, 1>, pg8::StaticOrderT<M, DM, 4>, true, true, FF, true>(lds, g, S, E, wave); }
          else { EpiResid<0, 1, 0> E{X, X, modl + 2 * DM, nullptr}; pg8::gemm_phase<EpiResid<0, 1, 0>, pg8::StaticOrderT<M, DM, 4>, true, true, FF, true>(lds, g, S, E, wave); } }
        GRID_BAR();
        norm_mod_fold_phase(X, modl, 3, 4, H, HE, HO, gw, NGW, xb_lane());
        GRID_BAR();
        { pg8::Gemm g{(const bf16*)(wl + W_F), HE, 1024, 8192, DM}; pg8::StaticOrderT<1024, 8192> S; S.init(G, bx);
          EpiUT E{UT}; pg8::gemm_phase<EpiUT, pg8::StaticOrderT<1024, 8192>, true, true, DM>(lds, g, S, E, wave); }
        { pg8::Gemm g{(const bf16*)(wl + W_F) + (size_t)1024 * DM, HO, 1024, 8192, DM}; pg8::StaticOrderT<1024, 8192> S; S.init(G, (bx + G / 2) % G);
          EpiUT E{UT + (size_t)2 * 4096 * 1024}; pg8::gemm_phase<EpiUT, pg8::StaticOrderT<1024, 8192>, true, true, DM>(lds, g, S, E, wave); }
        nyq_phase(H, (const bf16*)(wl + W_F), nyq, gw, NGW, xb_lane());
        { pg8::Gemm g{H, (const bf16*)(wl + W_QKV), M, 3072, DM}; pg8::StaticOrderT<M, 3072, 4> S; S.init(G, bx);
          EpiQKV E{Qb, Kb, Vb, rc, rsn}; pg8::gemm_phase<EpiQKV, pg8::StaticOrderT<M, 3072, 4>, true, true, DM>(lds, g, S, E, wave); }
        GRID_BAR();
#ifndef ATTN_REP
#define ATTN_REP 1
#endif
        for (int rep_ = 0; rep_ < ATTN_REP; ++rep_)
        attn_phase(lds, Qb, Kb, Vb, OP, LSE, wave, xb_lane(), bx, G);
        for (int mq = 0; mq < 4; ++mq) {
            pg8::Gemm g{Dm + (size_t)mq * 1024 * 1024, UT + (size_t)mq * 4096 * 1024, 1024, 4096, 1024}; pg8::StaticOrderT<1024, 4096> S; S.init(G, (bx + G - (G / 4) * mq) % G);
            EpiPQ E{PQ + (size_t)mq * 1024 * 4096}; pg8::gemm_phase<EpiPQ, pg8::StaticOrderT<1024, 4096>, true, true, 1024>(lds, g, S, E, wave); }
        quarter_row_phase(UT, UT + (size_t)3 * 4096 * 1024, yN, yN + 4096, gw, NGW, xb_lane());
        GRID_BAR();
        combine_phase(PQ, nyq, yN, yN + 4096, OP, LSE, YF, gw, NGW, xb_lane());
        GRID_BAR();
        { pg8::Gemm g{YF, (const bf16*)(wl + W_OF), M, DM, DM}; pg8::StaticOrderT<M, DM, 4> S; S.init(G, bx);
          EpiResid<0, 0, 0> E{X, X, modl + 5 * DM, nullptr}; pg8::gemm_phase<EpiResid<0, 0, 0>, pg8::StaticOrderT<M, DM, 4>, true, true, DM>(lds, g, S, E, wave); }
        GRID_BAR();
        norm_mod_phase<0>(X, modl, 6, 7, H, gw, NGW, xb_lane());
        GRID_BAR();
        { pg8::Gemm g{H, (const bf16*)(wl + W_GU2), M, 2 * FF, DM}; pg8::StaticOrderT<M, 2 * FF> S; S.init(G, bx);
          EpiSwiGLU E{ACT}; pg8::gemm_phase<EpiSwiGLU, pg8::StaticOrderT<M, 2 * FF>, true, true, DM>(lds, g, S, E, wave); }
        GRID_BAR();
        { pg8::Gemm g{ACT + (FF - 64), (const bf16*)(wl + W_D2) + (FF - 64), M, DM, FF}; pg8::StaticOrderT<M, DM, 4> S; S.init(G, bx);
          EpiResid<0, 1, 0> E{X, X, modl + 8 * DM, nullptr}; pg8::gemm_phase<EpiResid<0, 1, 0>, pg8::StaticOrderT<M, DM, 4>, true, true, FF, true>(lds, g, S, E, wave); }
        GRID_BAR();
    }
    { const int lane_f = xb_lane(); asm volatile("" ::: "memory");
      final_norm_phase((const bf16*)(ws + WS_X), args.in[13], args.out, gw, NGW, lane_f); }
}

extern "C" void kernel_launch(void* const* d_in, const int* in_sizes, int n_in, void* d_out, int out_size, void* d_ws, size_t ws_size, hipStream_t stream) {
    static int grid = 0;
    if (grid == 0) {
        if (n_in != 14 || in_sizes[0] != M * DM || out_size != M * DM || ws_size < WS_END) { fprintf(stderr, "kernel_launch: shape mismatch (n_in %d in0 %d out %d ws %zu, need ws >= %zu)\n", n_in, n_in > 0 ? in_sizes[0] : -1, out_size, ws_size, (size_t)WS_END); grid = -1; return; }
        int dev = 0, cus = 0, per_cu = 0;
        if (hipGetDevice(&dev) != hipSuccess || hipDeviceGetAttribute(&cus, hipDeviceAttributeMultiprocessorCount, dev) != hipSuccess) { fprintf(stderr, "kernel_launch: device query failed\n"); grid = -1; return; }
        if (hipFuncSetAttribute((const void*)hybrid_fwd, hipFuncAttributeMaxDynamicSharedMemorySize, LDS_BYTES) != hipSuccess) { fprintf(stderr, "kernel_launch: hipFuncSetAttribute failed\n"); grid = -1; return; }
        if (hipOccupancyMaxActiveBlocksPerMultiprocessor(&per_cu, (const void*)hybrid_fwd, NWAVES * 64, LDS_BYTES) != hipSuccess || per_cu < 1) { fprintf(stderr, "kernel_launch: occupancy query reports %d workgroups per CU\n", per_cu); }
        (void)hipGetLastError();
        grid = cus;
    }
    if (grid < 0) return;
    if (hipMemsetAsync((char*)d_ws + WS_CTL, 0, CTL_ZERO_BYTES, stream) != hipSuccess) { fprintf(stderr, "kernel_launch: memset failed\n"); return; }
    Args a{};
    for (int i = 0; i < 14; ++i) a.in[i] = (const float*)d_in[i];
    a.out = (float*)d_out; a.ws = (unsigned char*)d_ws;
    hipLaunchKernelGGL(hybrid_fwd, dim3(grid), dim3(NWAVES * 64), LDS_BYTES, stream, a);
    const hipError_t le = hipPeekAtLastError();
    if (le != hipSuccess) fprintf(stderr, "kernel_launch: launch failed: %s\n", hipGetErrorName(le));
}
```
